# Optimizing an MI355X kernel written in HIP

```python
import math
import jax, jax.numpy as jnp
from jax import lax
import numpy as np

D_MODEL = 1024
BATCH = 8
SEQ = 4096
DEPTH = 1

D_MIX = D_MODEL
A_HEADS = 8
A_HEAD_DIM = 64
D_A = A_HEADS * A_HEAD_DIM
B_GROUPS = 8
B_GROUP_DIM = 64
D_B = B_GROUPS * B_GROUP_DIM
D_IN = 2 * D_A + D_B
CHUNK = 128

N_EXPERTS = 64
TOP_K = 8
N_EXPERT_GROUPS = 8
TOPK_GROUPS = 4
D_EXPERT = 256
D_SHARED = 256
ROUTED_SCALE = 2.5
EXPERT_BLOCK = 128
EPS = 1e-6

kernel_name = "hybrid_sgu_fnet_moe_encoder"


def rms_norm(x, g):
    xf = x.astype(jnp.float32)
    y = xf * lax.rsqrt(jnp.mean(xf * xf, axis=-1, keepdims=True) + EPS)
    return (y * g.astype(jnp.float32)).astype(x.dtype)


def layer_norm(x, g, b):
    xf = x.astype(jnp.float32)
    mu = jnp.mean(xf, axis=-1, keepdims=True)
    xc = xf - mu
    y = xc * lax.rsqrt(jnp.mean(xc * xc, axis=-1, keepdims=True) + EPS)
    return (y * g.astype(jnp.float32) + b.astype(jnp.float32)).astype(x.dtype)


def spatial_gating(z, ln_g, ln_b, w_s, b_s):
    u, v = jnp.split(z, 2, axis=-1)
    v = layer_norm(v, ln_g, ln_b)
    bsz, s, _ = v.shape
    v = v.reshape(bsz, s // CHUNK, CHUNK, A_HEADS, A_HEAD_DIM)
    mixed = jnp.einsum('hpq,bcqhd->bcphd', w_s, v) + b_s.T[None, None, :, :, None]
    return u * mixed.reshape(bsz, s, D_A)


def fourier_mix(z):
    bsz, s, _ = z.shape
    zf = z.astype(jnp.float32).reshape(bsz, s, B_GROUPS, B_GROUP_DIM)
    f = jnp.fft.fft2(zf, axes=(1, 3), norm='ortho')
    return jnp.real(f).reshape(bsz, s, D_B).astype(z.dtype)


def route(xf, w_router, router_bias):
    t = xf.shape[0]
    scores = jax.nn.sigmoid(xf.astype(jnp.float32) @ w_router.astype(jnp.float32))
    biased = scores + router_bias.astype(jnp.float32)
    grp = biased.reshape(t, N_EXPERT_GROUPS, N_EXPERTS // N_EXPERT_GROUPS)
    group_score = jnp.sum(lax.top_k(grp, 2)[0], axis=-1)
    _, gidx = lax.top_k(group_score, TOPK_GROUPS)
    gmask = jnp.sum(jax.nn.one_hot(gidx, N_EXPERT_GROUPS, dtype=jnp.float32), axis=1) > 0
    emask = jnp.repeat(gmask, N_EXPERTS // N_EXPERT_GROUPS, axis=1)
    masked = jnp.where(emask, biased, -jnp.inf)
    _, eidx = lax.top_k(masked, TOP_K)
    w = jnp.take_along_axis(scores, eidx, axis=1)
    w = w / jnp.sum(w, axis=-1, keepdims=True) * ROUTED_SCALE
    return eidx, w


def routed_experts(xf, eidx, gates, w_gate, w_up, w_down):
    t, d = xf.shape
    n_assign = t * TOP_K
    e_flat = eidx.reshape(n_assign)
    tok_flat = jnp.repeat(jnp.arange(t, dtype=jnp.int32), TOP_K)
    g_flat = gates.reshape(n_assign).astype(xf.dtype)
    order = jnp.argsort(e_flat)
    e_s = e_flat[order]
    tok_s = tok_flat[order]
    g_s = g_flat[order]
    counts = jnp.bincount(e_flat, length=N_EXPERTS)
    starts = jnp.cumsum(counts) - counts
    padded = (counts + EXPERT_BLOCK - 1) // EXPERT_BLOCK * EXPERT_BLOCK
    pad_ends = jnp.cumsum(padded)
    pad_starts = pad_ends - padded
    dest = pad_starts[e_s] + (jnp.arange(n_assign, dtype=jnp.int32) - starts[e_s])
    total = n_assign + N_EXPERTS * EXPERT_BLOCK
    n_blocks = total // EXPERT_BLOCK
    buf_tok = jnp.full((total,), t, jnp.int32).at[dest].set(tok_s)
    buf_gate = jnp.zeros((total,), xf.dtype).at[dest].set(g_s)
    block_e = jnp.minimum(
        jnp.searchsorted(pad_ends, jnp.arange(n_blocks, dtype=jnp.int32) * EXPERT_BLOCK, side='right'),
        N_EXPERTS - 1)
    x_pad = jnp.concatenate([xf, jnp.zeros((1, d), xf.dtype)], axis=0)

    def step(y, blk):
        tok, gate, e = blk
        xb = x_pad[tok]
        h = jax.nn.silu(xb @ w_gate[e]) * (xb @ w_up[e])
        out = (h @ w_down[e]) * gate[:, None]
        return y.at[tok].add(out), None

    y0 = jnp.zeros((t + 1, d), xf.dtype)
    y, _ = lax.scan(step, y0, (buf_tok.reshape(n_blocks, EXPERT_BLOCK),
                               buf_gate.reshape(n_blocks, EXPERT_BLOCK), block_e))
    return y[:t]


def setup_inputs(seed: int = 0) -> dict:
    key = jax.random.key(seed)
    ks = jax.random.split(key, 22)
    f32 = jnp.float32
    L = DEPTH

    def nrm(k, shape, scale):
        return jax.random.normal(k, shape, f32) * scale

    return {
        "x": jax.random.normal(ks[0], (BATCH, SEQ, D_MODEL), f32),
        "norm1_g": 1.0 + nrm(ks[1], (L, D_MODEL), 0.01),
        "w_in": nrm(ks[2], (L, D_MODEL, D_IN), D_MODEL ** -0.5),
        "sgu_ln_g": 1.0 + nrm(ks[3], (L, D_A), 0.01),
        "sgu_ln_b": nrm(ks[4], (L, D_A), 0.02),
        "w_spatial": nrm(ks[5], (L, A_HEADS, CHUNK, CHUNK), CHUNK ** -0.5),
        "b_spatial": 1.0 + nrm(ks[6], (L, A_HEADS, CHUNK), 0.01),
        "out_norm_a_g": 1.0 + nrm(ks[7], (L, D_A), 0.01),
        "out_norm_b_g": 1.0 + nrm(ks[8], (L, D_B), 0.01),
        "w_out": nrm(ks[9], (L, D_MIX, D_MODEL), D_MIX ** -0.5),
        "norm2_g": 1.0 + nrm(ks[10], (L, D_MODEL), 0.01),
        "w_router": nrm(ks[11], (L, D_MODEL, N_EXPERTS), D_MODEL ** -0.5),
        "router_bias": nrm(ks[12], (L, N_EXPERTS), 0.01),
        "w_gate": nrm(ks[13], (L, N_EXPERTS, D_MODEL, D_EXPERT), D_MODEL ** -0.5),
        "w_up": nrm(ks[14], (L, N_EXPERTS, D_MODEL, D_EXPERT), D_MODEL ** -0.5),
        "w_down": nrm(ks[15], (L, N_EXPERTS, D_EXPERT, D_MODEL), D_EXPERT ** -0.5),
        "ws_gate": nrm(ks[16], (L, D_MODEL, D_SHARED), D_MODEL ** -0.5),
        "ws_up": nrm(ks[17], (L, D_MODEL, D_SHARED), D_MODEL ** -0.5),
        "ws_down": nrm(ks[18], (L, D_SHARED, D_MODEL), D_SHARED ** -0.5),
        "final_norm_g": 1.0 + nrm(ks[19], (D_MODEL,), 0.01),
    }


def reference(x, norm1_g, w_in, sgu_ln_g, sgu_ln_b, w_spatial, b_spatial,
              out_norm_a_g, out_norm_b_g, w_out, norm2_g, w_router, router_bias,
              w_gate, w_up, w_down, ws_gate, ws_up, ws_down, final_norm_g):
    bsz, s, d = x.shape
    h = x
    for l in range(DEPTH):
        xn = rms_norm(h, norm1_g[l])
        z = jnp.einsum('bsd,de->bse', xn, w_in[l])
        z_a = jax.nn.gelu(z[..., :2 * D_A], approximate=False)
        z_b = z[..., 2 * D_A:]
        y_a = spatial_gating(z_a, sgu_ln_g[l], sgu_ln_b[l], w_spatial[l], b_spatial[l])
        y_b = fourier_mix(z_b)
        mix = jnp.concatenate([rms_norm(y_a, out_norm_a_g[l]),
                               rms_norm(y_b, out_norm_b_g[l])], axis=-1)
        h = h + jnp.einsum('bse,ed->bsd', mix, w_out[l])
        hn = rms_norm(h, norm2_g[l]).reshape(bsz * s, d)
        eidx, gates = route(hn, w_router[l], router_bias[l])
        routed = routed_experts(hn, eidx, gates, w_gate[l], w_up[l], w_down[l])
        shared = (jax.nn.silu(hn @ ws_gate[l]) * (hn @ ws_up[l])) @ ws_down[l]
        h = h + (routed + shared).reshape(bsz, s, d)
    return rms_norm(h, final_norm_g)
```

```cpp
#include <hip/hip_runtime.h>
#include <cstdio>
#include <cstdint>

#ifndef MK_N_LAUNCHES
#define MK_N_LAUNCHES 1
#endif
#ifndef DBG_STOP
#define DBG_STOP 99
#endif

#define GAS __attribute__((address_space(1)))
#define LAS __attribute__((address_space(3)))
typedef unsigned short bf16;
typedef unsigned v4u __attribute__((ext_vector_type(4)));
typedef unsigned v2u __attribute__((ext_vector_type(2)));
typedef float f32x4 __attribute__((ext_vector_type(4)));
typedef float f32x2 __attribute__((ext_vector_type(2)));
typedef short bf16x8 __attribute__((ext_vector_type(8)));

constexpr int T = 32768, D = 1024, DIN = 1536, DA = 512, NE = 64, DE = 256, SEQ = 4096, NB_ = 8;
constexpr float EPS = 1e-6f;
constexpr int NCOLF = 8 * 8 * 33;
constexpr float CSCALE = 16.0f, CINV = 1.0f / 16.0f;

constexpr size_t MiB = 1u << 20;
constexpr size_t WS_CTL = 0, CTL_ZERO_BYTES = 65536;
constexpr size_t WS_WIN = 1 * MiB;
constexpr size_t WS_WOUT = 4 * MiB;
constexpr size_t WS_WR = 6 * MiB;
constexpr size_t WS_WSB = 6 * MiB + 256 * 1024;
constexpr size_t WS_TW = 6 * MiB + 512 * 1024;
constexpr size_t WS_RSTD2 = 6 * MiB + 768 * 1024;
constexpr int FB_OFF = 0, GT_OFF = 34816, TWL_OFF = 52224, XI_OFF = 68608, XI_SZ = 18432, TI_OFF = 105472, FPITCH = 272, XPITCH = 144;
constexpr size_t WS_F2IMG = 7 * MiB;
constexpr size_t WS_RSTD1 = 6 * MiB + 896 * 1024;
constexpr size_t WS_SSP = 8 * MiB;
constexpr size_t WS_LIST = 10 * MiB;
constexpr size_t WS_RSL = 18 * MiB;
constexpr size_t WS_GL = 26 * MiB;
constexpr size_t WS_TOKP = 34 * MiB;
constexpr size_t WS_WGU = 38 * MiB;
constexpr size_t WS_WD = 71 * MiB;
constexpr size_t WS_HB = 88 * MiB;
constexpr size_t WS_HB8 = 152 * MiB;
constexpr size_t WS_CONTRIB = 184 * MiB;
constexpr size_t WS_XN = 184 * MiB;
constexpr size_t WS_MIX = 411 * MiB;
constexpr size_t WS_Z = 248 * MiB;
constexpr size_t WS_CF = 344 * MiB;
constexpr size_t WS_YT = 378 * MiB;
constexpr size_t WS_CONTRIB9 = 440 * MiB;
constexpr size_t WS_TRASH = 6 * MiB + 512 * 1024 + 65536;
constexpr size_t WS_END = 512 * MiB;
constexpr float WSCALE = 64.0f, HSCALE = 8.0f;
__device__ __forceinline__ float sat8(float x) { return __builtin_amdgcn_fmed3f(x, -440.0f, 440.0f); }
constexpr int CW_BAR = 4096;
constexpr int CW_CNT = 8192;

constexpr int RING_BYTES = 131072;
constexpr int LDS_BYTES = 155648;
constexpr int MISC_OFF = LDS_BYTES - 1024;
constexpr int NWAVES = 8;

#define LDS_WAIT() asm volatile("s_waitcnt lgkmcnt(0)" ::: "memory")
#define VM_WAIT() asm volatile("s_waitcnt vmcnt(0)" ::: "memory")
#define LDS_BARRIER() do { asm volatile("s_waitcnt lgkmcnt(0)" ::: "memory"); __builtin_amdgcn_s_barrier(); asm volatile("" ::: "memory"); } while (0)
__device__ __forceinline__ unsigned f2bf(float f) { unsigned u = __builtin_bit_cast(unsigned, f); return (u + 0x7fffu + ((u >> 16) & 1u)) >> 16; }
__device__ __forceinline__ unsigned pk2(float lo, float hi) { return f2bf(lo) | (f2bf(hi) << 16); }
__device__ __forceinline__ float bflo(unsigned w) { return __builtin_bit_cast(float, w << 16); }
__device__ __forceinline__ float bfhi(unsigned w) { return __builtin_bit_cast(float, w & 0xffff0000u); }
__device__ __forceinline__ int lane_id() { int r; asm volatile("v_mbcnt_lo_u32_b32 %0, -1, 0\n\tv_mbcnt_hi_u32_b32 %0, -1, %0" : "=v"(r)); return r; }
template <int CTRL> __device__ __forceinline__ float dpp_f(float v) { return __builtin_bit_cast(float, __builtin_amdgcn_update_dpp(0, __builtin_bit_cast(int, v), CTRL, 0xF, 0xF, false)); }
template <int CTRL> __device__ __forceinline__ int dpp_i(int v) { return __builtin_amdgcn_update_dpp(0, v, CTRL, 0xF, 0xF, false); }
__device__ __forceinline__ float xor16_sum(float v) { const auto s = __builtin_amdgcn_permlane16_swap(__builtin_bit_cast(unsigned, v), __builtin_bit_cast(unsigned, v), false, false); return __builtin_bit_cast(float, (unsigned)s[0]) + __builtin_bit_cast(float, (unsigned)s[1]); }
__device__ __forceinline__ float xor32_sum(float v) { const auto s = __builtin_amdgcn_permlane32_swap(__builtin_bit_cast(unsigned, v), __builtin_bit_cast(unsigned, v), false, false); return __builtin_bit_cast(float, (unsigned)s[0]) + __builtin_bit_cast(float, (unsigned)s[1]); }
__device__ __forceinline__ float row16_sum(float v) { v += dpp_f<0xB1>(v); v += dpp_f<0x4E>(v); v += dpp_f<0x141>(v); v += dpp_f<0x140>(v); return v; }
__device__ __forceinline__ float wave_sum(float v) { return xor32_sum(xor16_sum(row16_sum(v))); }

namespace pg8 {
constexpr int BM = 256, BK = 64, HALF = 128, HTB = HALF * BK * 2, STAGE_BYTES = 8 * HTB;
__host__ __device__ __forceinline__ int lds_byte(int r, int c) { const int st = (r >> 4) * 2 + (c >> 5), rr = r & 15, cc = c & 31, ob = rr * 64 + cc * 2; return st * 1024 + (ob ^ (((ob >> 9) & 1) << 5)); }
__host__ __device__ __forceinline__ void stage_rc(int b, int& R, int& C) { const int st = b / 1024, sb = b % 1024, swz = sb ^ (((sb >> 9) & 1) << 5); R = (st >> 1) * 16 + swz / 64; C = (st & 1) * 32 + (swz % 64) / 2; }
__host__ __device__ __forceinline__ int perm32(int rho) { const int n = rho >> 4, i = rho & 15; return 8 * (i >> 2) + 4 * n + (i & 3); }
__host__ __device__ __forceinline__ int perm32b(int rho) { const int n = rho >> 4, i = rho & 15, q = i >> 2; return 16 * (q & 1) + 8 * (q >> 1) + 4 * n + (i & 3); }

struct Unit { const char* A; const char* B; int pm, pn, e, nvalid; };

__device__ __forceinline__ unsigned cvt_pk_bf16(float lo, float hi) { unsigned r; asm volatile("v_cvt_pk_bf16_f32 %0, %1, %2" : "=v"(r) : "v"(lo), "v"(hi)); return r; }
__device__ __forceinline__ f32x2 gelu_pk(f32x2 v) {
    const f32x2 av = __builtin_elementwise_abs(v), d = av * 0.2316418882f + 1.0f;
    f32x2 t; t.x = __builtin_amdgcn_rcpf(d.x); t.y = __builtin_amdgcn_rcpf(d.y);
    f32x2 q = t * 0.5307027145f + (-0.7265760135f); q = q * t + 0.7107068705f; q = q * t + (-0.142248368f); q = q * t + 0.127414796f; q = q * t;
    const f32x2 s = (v * v) * (-0.72134752044f);
    f32x2 e; e.x = __builtin_amdgcn_exp2f(s.x); e.y = __builtin_amdgcn_exp2f(s.y);
    const f32x2 m = v * (q * e), r = v - m;
    f32x2 o; o.x = v.x < 0.f ? m.x : r.x; o.y = v.y < 0.f ? m.y : r.y; return o;
}

typedef int v8i32 __attribute__((ext_vector_type(8)));
typedef unsigned v8u32 __attribute__((ext_vector_type(8)));
template <class Epi, class Sched, bool ALIGN_EPI, bool GATHER, bool FP8 = false>
__device__ __forceinline__ void gemm_phase(LAS unsigned char* lds, const Sched& S, const Epi& E, int wid) {
    const int lane = lane_id(), tid = wid * 64 + lane, wr = wid >> 2, wc = wid & 3, fr = lane & 15, fq = lane >> 4;
    const int K = S.K, nt = K / BK, lda = S.lda, ldb = S.ldb;
    unsigned voffA[2], voffB[2]; int RA[2];
#pragma unroll
    for (int i = 0; i < 2; ++i) { int R, C; stage_rc(tid * 16 + i * 8192, R, C); const int Rb = Epi::PERM == 2 ? ((R & ~31) + perm32b(R & 31)) : (Epi::PERM ? ((R & ~31) + perm32(R & 31)) : R);
        const int Ra = Epi::PERM_A ? ((R & ~31) + perm32(R & 31)) : R;
        voffA[i] = GATHER ? (unsigned)(C * 2) : (unsigned)(Ra * lda + C) * 2u; voffB[i] = (unsigned)(Rb * ldb + C) * 2u; RA[i] = R; }
    const size_t kstep = (size_t)(BK * 2);
    const size_t hstepA = (size_t)HALF * lda * 2, hstepB = (size_t)HALF * ldb * 2;
    const unsigned ldsw = (unsigned)wid * 1024u;
    const int aoff = lds_byte(wr * 64 + fr, fq * 8), boff = lds_byte(wc * 32 + fr, fq * 8);
#define PG8_SA(b, h) (((b) * 2 + (h)) * HTB)
#define PG8_SB(b, h) ((4 + (b) * 2 + (h)) * HTB)
#define PG8_GLDS(gp, bufoff, i_) __builtin_amdgcn_global_load_lds((const unsigned*)(gp), (LAS unsigned*)(lds + (bufoff) + ldsw + (i_) * 8192), 16, 0, 0)
#define PG8_STAGE_B(bufoff, gbase) do { PG8_GLDS((const char*)(gbase) + voffB[0], bufoff, 0); PG8_GLDS((const char*)(gbase) + voffB[1], bufoff, 1); } while (0)
#define PG8_STAGE_A(bufoff, gbase, h_, o_) do { if constexpr (GATHER) { PG8_GLDS((const char*)(gbase) + ((o_[h_] & 0x7fffu) * (unsigned)(lda * 2) + voffA[0]), bufoff, 0); PG8_GLDS((const char*)(gbase) + (((o_[h_] >> 16) & 0x7fffu) * (unsigned)(lda * 2) + voffA[1]), bufoff, 1); } \
        else { PG8_GLDS((const char*)(gbase) + (h_) * hstepA + voffA[0], bufoff, 0); PG8_GLDS((const char*)(gbase) + (h_) * hstepA + voffA[1], bufoff, 1); } } while (0)
#define PG8_LD8(p_) __builtin_shufflevector(*(const LAS v4u*)(p_), *(const LAS v4u*)((p_) + 1024), 0, 1, 2, 3, 4, 5, 6, 7)
#define PG8_LDA(dst, b, h) do { _Pragma("unroll") for (int m = 0; m < 4; ++m) dst[m] = PG8_LD8(lds + PG8_SA(b, h) + aoff + m * 2048); } while (0)
#define PG8_LDB(dst, b, h) do { _Pragma("unroll") for (int n = 0; n < 2; ++n) dst[n] = PG8_LD8(lds + PG8_SB(b, h) + boff + n * 2048); } while (0)
#define PG8_MMA(ai, bj, At, Bt) do { __builtin_amdgcn_s_setprio(1); _Pragma("unroll") for (int m = 0; m < 4; ++m) _Pragma("unroll") for (int n = 0; n < 2; ++n) { \
        if constexpr (FP8) { acc[ai][bj][m][n] = __builtin_amdgcn_mfma_scale_f32_16x16x128_f8f6f4(__builtin_bit_cast(v8i32, Bt[n]), __builtin_bit_cast(v8i32, At[m]), acc[ai][bj][m][n], 0, 0, 0, Epi::SCALE_B, 0, Epi::SCALE_A); } \
        else { acc[ai][bj][m][n] = __builtin_amdgcn_mfma_f32_16x16x32_bf16(__builtin_bit_cast(bf16x8, __builtin_shufflevector(Bt[n], Bt[n], 0, 1, 2, 3)), __builtin_bit_cast(bf16x8, __builtin_shufflevector(At[m], At[m], 0, 1, 2, 3)), acc[ai][bj][m][n], 0, 0, 0); \
               acc[ai][bj][m][n] = __builtin_amdgcn_mfma_f32_16x16x32_bf16(__builtin_bit_cast(bf16x8, __builtin_shufflevector(Bt[n], Bt[n], 4, 5, 6, 7)), __builtin_bit_cast(bf16x8, __builtin_shufflevector(At[m], At[m], 4, 5, 6, 7)), acc[ai][bj][m][n], 0, 0, 0); } } \
        if constexpr (FP8) { _Pragma("unroll") for (int m = 0; m < 4; ++m) _Pragma("unroll") for (int n = 0; n < 2; ++n) asm volatile("" : "+v"(acc[ai][bj][m][n])); }     \
        __builtin_amdgcn_s_setprio(0); } while (0)
#define PG8_MMAT(ai, bj, At, Bt) do { __builtin_amdgcn_s_setprio(1); _Pragma("unroll") for (int m = 0; m < 4; ++m) _Pragma("unroll") for (int n = 0; n < 2; ++n) { \
        acc[ai][bj][m][n] = __builtin_amdgcn_mfma_f32_16x16x32_bf16(__builtin_bit_cast(bf16x8, __builtin_shufflevector(At[m], At[m], 0, 1, 2, 3)), __builtin_bit_cast(bf16x8, __builtin_shufflevector(Bt[n], Bt[n], 0, 1, 2, 3)), acc[ai][bj][m][n], 0, 0, 0); \
        acc[ai][bj][m][n] = __builtin_amdgcn_mfma_f32_16x16x32_bf16(__builtin_bit_cast(bf16x8, __builtin_shufflevector(At[m], At[m], 4, 5, 6, 7)), __builtin_bit_cast(bf16x8, __builtin_shufflevector(Bt[n], Bt[n], 4, 5, 6, 7)), acc[ai][bj][m][n], 0, 0, 0); } \
        __builtin_amdgcn_s_setprio(0); } while (0)
#define PG8_WAIT_V(n) asm volatile("s_waitcnt vmcnt(" #n ")" ::: "memory")
#define PG8_WAIT_L(n) asm volatile("s_waitcnt lgkmcnt(" #n ")" ::: "memory")
#define PG8_BAR __builtin_amdgcn_s_barrier()
#define PG8_SCHED __builtin_amdgcn_sched_barrier(0)
#define PG8_KLOOP(MMAX) \
        for (int t = 0; t < nt; t += 2) { \
            const bool last = (t == nt - 2); \
            const char* a1 = cA + (size_t)(t + 1) * kstep; \
            const char* a2 = last ? nA : cA + (size_t)(t + 2) * kstep; const char* b2 = last ? nB : cB + (size_t)(t + 2) * kstep; \
            const char* a3 = a2 + kstep; const char* b3 = b2 + kstep; \
            unsigned o2[2]; \
_Pragma("unroll") \
            for (int h = 0; h < 2; ++h) o2[h] = last ? on[h] : oc[h]; \
            PG8_LDB(B0, 0, 0); PG8_LDB(B1, 0, 1); PG8_SCHED; PG8_LDA(At, 0, 0); PG8_STAGE_A(PG8_SA(1, 1), a1, 1, oc); \
            PG8_WAIT_V(8); PG8_WAIT_L(0); PG8_BAR; MMAX(0, 0, At, B0); MMAX(0, 1, At, B1); PG8_BAR; PG8_SCHED; \
            PG8_LDA(At, 0, 1); PG8_STAGE_B(PG8_SB(0, 0), b2); PG8_STAGE_B(PG8_SB(0, 1), b2 + hstepB); PG8_STAGE_A(PG8_SA(0, 0), a2, 0, o2); \
            PG8_WAIT_V(8); PG8_WAIT_L(0); PG8_BAR; MMAX(1, 0, At, B0); MMAX(1, 1, At, B1); PG8_BAR; PG8_SCHED; \
            PG8_LDB(B0, 1, 0); PG8_LDB(B1, 1, 1); PG8_SCHED; PG8_LDA(At, 1, 0); PG8_STAGE_A(PG8_SA(0, 1), a2, 1, o2); \
            PG8_WAIT_V(8); PG8_WAIT_L(0); PG8_BAR; MMAX(0, 0, At, B0); MMAX(0, 1, At, B1); PG8_BAR; PG8_SCHED; \
            PG8_LDA(At, 1, 1); PG8_STAGE_B(PG8_SB(1, 0), b3); PG8_STAGE_B(PG8_SB(1, 1), b3 + hstepB); PG8_STAGE_A(PG8_SA(1, 0), a3, 0, o2); \
            PG8_WAIT_V(8); PG8_WAIT_L(0); PG8_BAR; MMAX(1, 0, At, B0); MMAX(1, 1, At, B1); PG8_BAR; PG8_SCHED; \
        }
    Unit cur, nxt; int ui = 0;
    if (!S.next(0, cur)) return;
    f32x4 acc[2][2][4][2];
#pragma unroll
    for (int a = 0; a < 2; ++a)
#pragma unroll
        for (int b = 0; b < 2; ++b)
#pragma unroll
            for (int m = 0; m < 4; ++m)
#pragma unroll
                for (int n = 0; n < 2; ++n) acc[a][b][m][n] = (f32x4){0.f, 0.f, 0.f, 0.f};
    v8u32 At[4], B0[2], B1[2];
    unsigned oc[2], on[2];
#pragma unroll
    for (int h = 0; h < 2; ++h) { oc[h] = GATHER ? S.gather2(cur, h, RA[0]) : 0u; on[h] = oc[h]; }
    const char* cA = cur.A; const char* cB = cur.B;
    PG8_STAGE_B(PG8_SB(0, 0), cB); PG8_STAGE_B(PG8_SB(0, 1), cB + hstepB); PG8_STAGE_A(PG8_SA(0, 0), cA, 0, oc); PG8_STAGE_A(PG8_SA(0, 1), cA, 1, oc);
    if (wr == 1) PG8_BAR;
    PG8_WAIT_V(2); PG8_BAR;
    PG8_STAGE_B(PG8_SB(1, 0), cB + kstep); PG8_STAGE_A(PG8_SA(1, 0), cA + kstep, 0, oc); PG8_STAGE_B(PG8_SB(1, 1), cB + hstepB + kstep);
    PG8_WAIT_V(6); PG8_BAR;
    for (;;) {
        const bool has_next = S.next(ui + 1, nxt);
        const char* nA = has_next ? nxt.A : cA; const char* nB = has_next ? nxt.B : cB;
        if constexpr (GATHER) {
            if (has_next) {
#pragma unroll
                for (int h = 0; h < 2; ++h) on[h] = S.gather2(nxt, h, RA[0]);
            }
        }
        unsigned pf[2];
        if constexpr (Epi::PREFETCH) E.prefetch(cur, wr, fr, fq, pf);
        if constexpr (Epi::DUAL) { if (E.transposed(cur)) { PG8_KLOOP(PG8_MMAT) } else { PG8_KLOOP(PG8_MMA) } } else { PG8_KLOOP(PG8_MMA) }
        if constexpr (ALIGN_EPI) { if (wr == 0) PG8_BAR; }
        if constexpr (Epi::DUAL) { if (E.transposed(cur)) E.epiT(acc, cur, wr, wc, fr, fq); else E(acc, cur, wr, wc, fr, fq); }
        else if constexpr (Epi::PREFETCH) E(acc, cur, wr, wc, fr, fq, pf); else E(acc, cur, wr, wc, fr, fq);
        if (!has_next) break;
#pragma unroll
        for (int a = 0; a < 2; ++a)
#pragma unroll
            for (int b = 0; b < 2; ++b)
#pragma unroll
                for (int m = 0; m < 4; ++m)
#pragma unroll
                    for (int n = 0; n < 2; ++n) acc[a][b][m][n] = (f32x4){0.f, 0.f, 0.f, 0.f};
        cur = nxt; cA = nA; cB = nB; ++ui;
        oc[0] = on[0]; oc[1] = on[1];
        if constexpr (ALIGN_EPI) { if (wr == 1) PG8_BAR; }
    }
    PG8_WAIT_V(0);
    if constexpr (!ALIGN_EPI) { if (wr == 0) PG8_BAR; }
    PG8_BAR;
#undef PG8_SA
#undef PG8_SB
#undef PG8_GLDS
#undef PG8_STAGE_A
#undef PG8_STAGE_B
#undef PG8_LDA
#undef PG8_LDB
#undef PG8_MMA
#undef PG8_MMAT
#undef PG8_KLOOP
#undef PG8_WAIT_V
#undef PG8_WAIT_L
#undef PG8_BAR
#undef PG8_SCHED
}
}

#define XB_TMO      128
#define XB_XCNT(j)  (256  + 64 * (j))
#define XB_XSUB(j)  (1280 + 64 * (j))
#define XB_XGEN(j)  (2304 + 64 * (j))
#define XB_TOP      3328
#define XB_TOPGEN   3392
#define XCD_BAR_WORDS 3456
#define XB_SPIN_CAP (1u << 18)
__device__ __forceinline__ unsigned xb_ld(unsigned* p)              { return __hip_atomic_load(p, __ATOMIC_RELAXED, __HIP_MEMORY_SCOPE_AGENT); }
__device__ __forceinline__ unsigned xb_add(unsigned* p, unsigned v) { return __hip_atomic_fetch_add(p, v, __ATOMIC_RELAXED, __HIP_MEMORY_SCOPE_AGENT); }
__device__ __forceinline__ unsigned xb_xcc_id() { return (unsigned)__builtin_amdgcn_s_getreg((3 << 11) | 20) & 0xFu; }
#define XB_SPIN(cond, bar) do { unsigned _sp = 0; while (cond) { __builtin_amdgcn_s_sleep(1); \
    if ((++_sp & 255u) == 0u) { if (xb_ld(&(bar)[XB_TMO])) break; if (_sp > XB_SPIN_CAP) { atomicAdd(&(bar)[XB_TMO], 1u); break; } } } } while (0)
struct XcdBarrier { unsigned* bar; unsigned x; volatile LAS unsigned* st; int wave; };
__device__ __forceinline__ XcdBarrier xcd_barrier_post(unsigned* bar, volatile LAS unsigned* st, int wave) {
    XcdBarrier b; b.bar = bar; b.x = xb_xcc_id(); b.st = st; b.wave = wave;
    if (wave == 0 && lane_id() == 0) (void)xb_add(&bar[XB_XCNT(b.x)], 1u);
    return b;
}
__device__ __forceinline__ void xcd_barrier_complete(unsigned* bar, unsigned x, unsigned& nloc, unsigned& nx) {
    const unsigned G = gridDim.x * gridDim.y * gridDim.z;
    unsigned sum, cnt, mine, sp = 0u;
    for (;;) {
        sum = 0u; cnt = 0u; mine = 0u;
#pragma unroll
        for (unsigned j = 0; j < 16; ++j) { const unsigned c = xb_ld(&bar[XB_XCNT(j)]); sum += c; cnt += (c > 0u) ? 1u : 0u; mine = (j == x) ? c : mine; }
        if (sum == G) break;
        __builtin_amdgcn_s_sleep(1);
        if ((++sp & 255u) == 0u) { if (xb_ld(&bar[XB_TMO])) break; if (sp > XB_SPIN_CAP) { atomicAdd(&bar[XB_TMO], 1u); break; } }
    }
    nloc = mine > 0u ? mine : 1u; nx = cnt > 0u ? cnt : 1u;
}
__device__ __forceinline__ void xcd_barrier(const XcdBarrier& b) {
    asm volatile("s_waitcnt vmcnt(0)" ::: "memory");
    __syncthreads();
    if (b.wave == 0 && lane_id() == 0) {
        unsigned* bar = b.bar;
        __builtin_amdgcn_s_waitcnt(0);
        unsigned nloc = b.st[0], nx = b.st[1];
        if (nloc == 0u) { xcd_barrier_complete(bar, b.x, nloc, nx); b.st[0] = nloc; b.st[1] = nx; }
        const unsigned old = xb_add(&bar[XB_XSUB(b.x)], 1u);
        const unsigned gen = old / nloc;
        if (old + 1u == (gen + 1u) * nloc) {
            __builtin_amdgcn_fence(__ATOMIC_RELEASE, "agent");
            asm volatile("s_waitcnt vmcnt(0)" ::: "memory");
            const unsigned og = xb_add(&bar[XB_TOP], 1u);
            const unsigned tg = og / nx;
            if (og + 1u == (tg + 1u) * nx) xb_add(&bar[XB_TOPGEN], 1u);
            else XB_SPIN(xb_ld(&bar[XB_TOPGEN]) == tg, bar);
            __builtin_amdgcn_fence(__ATOMIC_ACQUIRE, "agent");
            xb_add(&bar[XB_XGEN(b.x)], 1u);
            asm volatile("s_waitcnt vmcnt(0)" ::: "memory");
        } else {
            XB_SPIN(xb_ld(&bar[XB_XGEN(b.x)]) == gen, bar);
            __builtin_amdgcn_fence(__ATOMIC_ACQUIRE, "agent");
            asm volatile("s_waitcnt vmcnt(0)" ::: "memory");
        }
    }
    __syncthreads();
}

struct Args { const float* in[20]; float* out; unsigned char* ws; int ph_lo, ph_hi, li, variant; };
struct Frame {
    LAS unsigned char* lds; volatile LAS unsigned* MISC; unsigned* ctl;
    int wave, G, c, variant;
    unsigned char* ws; float* out;
};
#define WSP(T_, off) ((T_*)(F.ws + (off)))
__device__ __forceinline__ const float* karg_in(int i) { return ((const float* const __attribute__((address_space(4)))*)__builtin_amdgcn_kernarg_segment_ptr())[i]; }

struct StaticOrder {
    const char* A; const char* B; int K, lda, ldb; int nM, nN, nwg, G, c;
    __device__ void init(const void* A_, const void* B_, int M, int N, int K_, int lda_, int ldb_, int G_, int c_) { A = (const char*)A_; B = (const char*)B_; K = K_; lda = lda_; ldb = ldb_; nM = M / 256; nN = N / 256; nwg = nM * nN; G = G_; c = c_; }
    __device__ __forceinline__ bool next(int i, pg8::Unit& u) const {
        const long L = (long)i * G + c; if (L >= nwg) return false;
        int wgid = (int)L; { const int q = nwg / 8, r = nwg % 8, xcd = wgid % 8, off = wgid / 8; wgid = (xcd < r ? xcd * (q + 1) : r * (q + 1) + (xcd - r) * q) + off; }
        const int nig = 8 * nN, gid = wgid / nig, fm = gid * 8, gsz = (nM - fm) < 8 ? (nM - fm) : 8;
        u.pm = fm + ((wgid % nig) % gsz); u.pn = (wgid % nig) / gsz; u.e = 0; u.nvalid = 256;
        u.A = A + (size_t)u.pm * 256 * lda * 2; u.B = B + (size_t)u.pn * 256 * ldb * 2; return true;
    }
    __device__ __forceinline__ unsigned gather2(const pg8::Unit&, int, int) const { return 0u; }
};
__device__ __forceinline__ int find_expert(const volatile LAS int* bst, int blk) { int lo = 0, hi = 65; while (hi - lo > 1) { const int mid = (lo + hi) >> 1; if (bst[mid] <= blk) lo = mid; else hi = mid; } return lo; }
struct SchedGU {
    const char* hb; const char* Wgu; const unsigned short* tokp; const unsigned* cnt; const volatile LAS int* bst;
    int K, lda, ldb, G, c, NU, Q;
    __device__ __forceinline__ bool next(int i, pg8::Unit& u) const {
        const int x = c & 7, j = c >> 3, per = G >> 3; const int L = x * Q + i * per + j; int hiL = (x + 1) * Q; hiL = hiL < NU ? hiL : NU;
        if (i * per + j >= Q || L >= hiL) return false;
        int lo = 0, hi = 65; while (hi - lo > 1) { const int mid = (lo + hi) >> 1; if (2 * bst[mid] <= L) lo = mid; else hi = mid; }
        const int e = lo, loc = L - 2 * bst[e], uu = loc & 1, rb = loc >> 1;
        u.e = e; u.pm = rb; u.pn = uu; u.A = hb; u.B = Wgu + ((size_t)e * 512 + uu * 256) * 1024;
        int nv = bst[66 + e] - rb * 256; nv = nv > 256 ? 256 : nv; u.nvalid = nv; return true;
    }
    __device__ __forceinline__ unsigned gather2(const pg8::Unit& u, int h, int R0) const {
        if (u.e >= 64) { const unsigned t = (unsigned)(u.pm * 256 + h * 128 + R0); return t | ((t + 64u) << 16); }
        return *(const unsigned*)(tokp + (size_t)u.e * 32768 + u.pm * 256 + h * 128 + 2 * R0);
    }
};
struct SchedDN {
    const char* hact_lo; const char* hact_hi; const char* Wd; const unsigned* cnt; const volatile LAS int* bst;
    int K, lda, ldb, G, c, NU, Q;
    __device__ __forceinline__ bool next(int i, pg8::Unit& u) const {
        const int x = c & 7, j = c >> 3, per = G >> 3; const int L = x * Q + i * per + j; int hiL = (x + 1) * Q; hiL = hiL < NU ? hiL : NU;
        if (i * per + j >= Q || L >= hiL) return false;
        const int blk = L >> 2, pn = L & 3; const int e = find_expert(bst, blk), rb = blk - bst[e];
        u.e = e; u.pm = rb; u.pn = pn;
        u.A = hact_lo + (size_t)blk * 65536;
        u.B = Wd + ((size_t)e * 1024 + pn * 256) * 256;
        int nv = bst[66 + e] - rb * 256; nv = nv > 256 ? 256 : nv; u.nvalid = nv; return true;
    }
    __device__ __forceinline__ unsigned gather2(const pg8::Unit&, int, int) const { return 0u; }
};

struct EpiZ {
    static constexpr bool PERM_A = true, DUAL = true;
    static constexpr int PERM = 1; static constexpr bool PREFETCH = false; static constexpr int SCALE_A = 0, SCALE_B = 0;
    bf16* Z; const float* rstd1; bf16* CF;
    __device__ __forceinline__ bool transposed(const pg8::Unit& u) const { return u.pn >= 4; }
    __device__ __forceinline__ void operator()(const f32x4 (&acc)[2][2][4][2], const pg8::Unit& u, int wr, int wc, int fr, int fq) const {
        const int row0 = u.pm * 256 + wr * 64 + 8 * (fr >> 2) + (fr & 3), col0 = u.pn * 256 + wc * 32 + 8 * fq;
        float rsv[8];
#pragma unroll
        for (int q = 0; q < 8; ++q) rsv[q] = rstd1[row0 + (q >> 2) * 128 + ((q >> 1) & 1) * 32 + (q & 1) * 4];
#pragma unroll
        for (int ai = 0; ai < 2; ++ai)
#pragma unroll
            for (int m = 0; m < 4; ++m) { bf16* rowp = Z + (size_t)(row0 + ai * 128 + (m >> 1) * 32 + (m & 1) * 4) * DIN + col0; const float rs = rsv[ai * 4 + m];
#pragma unroll
                for (int bj = 0; bj < 2; ++bj) { f32x4 v0 = acc[ai][bj][m][0] * rs, v1 = acc[ai][bj][m][1] * rs;
                    { f32x2 a = pg8::gelu_pk((f32x2){v0[0], v0[1]}), b = pg8::gelu_pk((f32x2){v0[2], v0[3]}), c = pg8::gelu_pk((f32x2){v1[0], v1[1]}), d = pg8::gelu_pk((f32x2){v1[2], v1[3]});
                        v0 = (f32x4){a.x, a.y, b.x, b.y}; v1 = (f32x4){c.x, c.y, d.x, d.y}; }
                    v4u w; w.x = pg8::cvt_pk_bf16(v0[0], v0[1]); w.y = pg8::cvt_pk_bf16(v0[2], v0[3]); w.z = pg8::cvt_pk_bf16(v1[0], v1[1]); w.w = pg8::cvt_pk_bf16(v1[2], v1[3]);
                    *(v4u*)(rowp + bj * 128) = w; } }
    }
    __device__ __forceinline__ void epiT(const f32x4 (&acc)[2][2][4][2], const pg8::Unit& u, int wr, int wc, int fr, int fq) const {
        const int t0 = u.pm * 256, b = t0 >> 12, s0 = (t0 & 4095) + wr * 64 + 8 * fq;
#pragma unroll
        for (int ai = 0; ai < 2; ++ai)
#pragma unroll
            for (int mp = 0; mp < 2; ++mp) { const int s = s0 + ai * 128 + mp * 32;
                const f32x4 r0 = *(const f32x4*)(rstd1 + b * 4096 + s), r1 = *(const f32x4*)(rstd1 + b * 4096 + s + 4);
#pragma unroll
                for (int bj = 0; bj < 2; ++bj)
#pragma unroll
                    for (int n = 0; n < 2; ++n) { const int cg = (u.pn - 4) * 256 + bj * 128 + wc * 32 + 8 * (fr >> 2) + 4 * n + (fr & 3), g = cg >> 6, j = cg & 63;
                        const int plane = ((b * 8 + g) * 33 + (j <= 32 ? j : j - 32)) * 2 + (j <= 32 ? 0 : 1);
                        const f32x4 v0 = acc[ai][bj][2 * mp][n] * r0, v1 = acc[ai][bj][2 * mp + 1][n] * r1;
                        v4u w; w.x = pg8::cvt_pk_bf16(v0[0], v0[1]); w.y = pg8::cvt_pk_bf16(v0[2], v0[3]); w.z = pg8::cvt_pk_bf16(v1[0], v1[1]); w.w = pg8::cvt_pk_bf16(v1[2], v1[3]);
                        *(v4u*)(CF + (size_t)plane * 4096 + s) = w; } }
    }
};
struct EpiH {
    static constexpr bool PERM_A = false, DUAL = false;
    static constexpr int PERM = 1; static constexpr bool PREFETCH = false; static constexpr int SCALE_A = 0, SCALE_B = 0;
    const bf16* XB; bf16* HB; float* SSP; unsigned char* HB8;
    __device__ __forceinline__ void operator()(const f32x4 (&acc)[2][2][4][2], const pg8::Unit& u, int wr, int wc, int fr, int fq) const {
        const int row0 = u.pm * 256 + wr * 64 + fr, col0 = u.pn * 256 + wc * 32 + 8 * fq;
#pragma unroll
        for (int ai = 0; ai < 2; ++ai)
#pragma unroll
            for (int m = 0; m < 4; ++m) { const int row = row0 + ai * 128 + m * 16; const size_t off = (size_t)row * D + col0; float ss = 0.f;
#pragma unroll
                for (int bj = 0; bj < 2; ++bj) { const v4u xw = __builtin_nontemporal_load((const v4u*)(XB + off + bj * 128));
                    const f32x4 x0 = (f32x4){bflo(xw.x), bfhi(xw.x), bflo(xw.y), bfhi(xw.y)}, x1 = (f32x4){bflo(xw.z), bfhi(xw.z), bflo(xw.w), bfhi(xw.w)};
                    const f32x4 v0 = acc[ai][bj][m][0] + x0, v1 = acc[ai][bj][m][1] + x1;
                    v4u w; w.x = pg8::cvt_pk_bf16(v0[0], v0[1]); w.y = pg8::cvt_pk_bf16(v0[2], v0[3]); w.z = pg8::cvt_pk_bf16(v1[0], v1[1]); w.w = pg8::cvt_pk_bf16(v1[2], v1[3]);
                    const float r0 = bflo(w.x), r1 = bfhi(w.x), r2 = bflo(w.y), r3 = bfhi(w.y), r4 = bflo(w.z), r5 = bfhi(w.z), r6 = bflo(w.w), r7 = bfhi(w.w);
                    ss += ((r0 * r0 + r1 * r1) + (r2 * r2 + r3 * r3)) + ((r4 * r4 + r5 * r5) + (r6 * r6 + r7 * r7));
                    *(v4u*)(HB + off + bj * 128) = w;
                    int q0 = __builtin_amdgcn_cvt_pk_fp8_f32(sat8(r0), sat8(r1), 0, false); q0 = __builtin_amdgcn_cvt_pk_fp8_f32(sat8(r2), sat8(r3), q0, true);
                    int q1 = __builtin_amdgcn_cvt_pk_fp8_f32(sat8(r4), sat8(r5), 0, false); q1 = __builtin_amdgcn_cvt_pk_fp8_f32(sat8(r6), sat8(r7), q1, true);
                    *(v2u*)(HB8 + off + bj * 128) = (v2u){(unsigned)q0, (unsigned)q1}; }
                ss = xor32_sum(xor16_sum(ss));
                if (fq == 0) SSP[(size_t)row * 16 + u.pn * 4 + wc] = ss; }
    }
};
struct EpiGU {
    static constexpr bool PERM_A = false, DUAL = false;
    static constexpr int PERM = 1; static constexpr bool PREFETCH = false;
    static constexpr int SCALE_A = 0x7F7F7F7F, SCALE_B = 0x79797979;
    const float* rsl; const float* rstd2; unsigned char* hact; const volatile LAS int* bst;
    __device__ __forceinline__ void operator()(const f32x4 (&acc)[2][2][4][2], const pg8::Unit& u, int wr, int wc, int fr, int fq) const {
        const int blk = bst[u.e] + u.pm; unsigned char* H = hact + (size_t)blk * 65536;
        const int col0 = u.pn * 128 + wc * 32 + 8 * fq;
        const float* rp = (u.e < 64) ? rsl + (size_t)u.e * 32768 + u.pm * 256 : rstd2 + u.pm * 256;
        float rsv[8];
#pragma unroll
        for (int q = 0; q < 8; ++q) rsv[q] = rp[(q >> 2) * 128 + wr * 64 + (q & 3) * 16 + fr];
#pragma unroll
        for (int ai = 0; ai < 2; ++ai)
#pragma unroll
            for (int m = 0; m < 4; ++m) { const int r = ai * 128 + wr * 64 + m * 16 + fr;
                const float rs = rsv[ai * 4 + m];
                const f32x4 g0 = acc[ai][0][m][0] * rs, g1 = acc[ai][0][m][1] * rs, u0 = acc[ai][1][m][0] * (rs * HSCALE), u1 = acc[ai][1][m][1] * (rs * HSCALE);
                float hv[8];
#pragma unroll
                for (int j = 0; j < 4; ++j) { hv[j] = sat8(g0[j] * __builtin_amdgcn_rcpf(1.0f + __builtin_amdgcn_exp2f(-1.44269504f * g0[j])) * u0[j]); hv[4 + j] = sat8(g1[j] * __builtin_amdgcn_rcpf(1.0f + __builtin_amdgcn_exp2f(-1.44269504f * g1[j])) * u1[j]); }
                int p0 = __builtin_amdgcn_cvt_pk_fp8_f32(hv[0], hv[1], 0, false); p0 = __builtin_amdgcn_cvt_pk_fp8_f32(hv[2], hv[3], p0, true);
                int p1 = __builtin_amdgcn_cvt_pk_fp8_f32(hv[4], hv[5], 0, false); p1 = __builtin_amdgcn_cvt_pk_fp8_f32(hv[6], hv[7], p1, true);
                *(v2u*)(H + (size_t)r * 256 + col0) = (v2u){(unsigned)p0, (unsigned)p1}; }
    }
};
struct EpiDN {
    static constexpr int PERM = 2;
    static constexpr bool PREFETCH = false; static constexpr int SCALE_A = 0x7C7C7C7C, SCALE_B = 0x79797979;
    const int* list; const float* gates; unsigned char* contrib; unsigned char* contrib9; unsigned char* trash;
    __device__ __forceinline__ void prefetch(const pg8::Unit& u, int wr, int fr, int fq, unsigned (&sgq)[2]) const {
        const unsigned* lp = (const unsigned*)list + (size_t)(u.e < 64 ? u.e : 0) * 32768 + u.pm * 256;
        sgq[0] = lp[wr * 64 + fq * 16 + fr]; sgq[1] = lp[128 + wr * 64 + fq * 16 + fr];
    }
    __device__ __forceinline__ void operator()(const f32x4 (&acc)[2][2][4][2], const pg8::Unit& u, int wr, int wc, int fr, int fq) const {
        unsigned sgp[8];
        { const unsigned* lp = (const unsigned*)list + (size_t)(u.e < 64 ? u.e : 0) * 32768 + u.pm * 256;
#pragma unroll
          for (int q = 0; q < 8; ++q) sgp[q] = lp[(q >> 2) * 128 + wr * 64 + (q & 3) * 16 + fr]; }
        const int col0 = u.pn * 256 + wc * 32 + 16 * (fq & 1) + 128 * (fq >> 1); const bool routed = u.e < 64;
#pragma unroll
        for (int ai = 0; ai < 2; ++ai) {
#pragma unroll
            for (int m = 0; m < 4; ++m) { const int r = ai * 128 + wr * 64 + m * 16 + fr; const float gs = routed ? (float)(sgp[ai * 4 + m] & 16383u) * (2.5f * CSCALE / 16383.0f) : CSCALE;
                unsigned char* cp = routed ? contrib + (size_t)(sgp[ai * 4 + m] >> 14) * 1024 : contrib9 + (size_t)(u.pm * 256 + r) * 1024;
                cp = (r < u.nvalid) ? cp : trash; cp += col0;
                unsigned pk[2][2];
#pragma unroll
                for (int bj = 0; bj < 2; ++bj) { const f32x4 v0 = acc[ai][bj][m][0] * gs, v1 = acc[ai][bj][m][1] * gs;
                    int p0 = __builtin_amdgcn_cvt_pk_fp8_f32(v0[0], v0[1], 0, false); p0 = __builtin_amdgcn_cvt_pk_fp8_f32(v0[2], v0[3], p0, true);
                    int p1 = __builtin_amdgcn_cvt_pk_fp8_f32(v1[0], v1[1], 0, false); p1 = __builtin_amdgcn_cvt_pk_fp8_f32(v1[2], v1[3], p1, true);
                    pk[bj][0] = (unsigned)p0; pk[bj][1] = (unsigned)p1; }
                const auto s0 = __builtin_amdgcn_permlane32_swap(pk[0][0], pk[1][0], false, false);
                const auto s1 = __builtin_amdgcn_permlane32_swap(pk[0][1], pk[1][1], false, false);
                *(v4u*)cp = (v4u){s0[0], s1[0], s0[1], s1[1]}; }
            asm volatile("" ::: "memory"); }
    }
};

__device__ __forceinline__ void p0_transpose_item(const float* W, int K, int N, bf16* WT, int row_off_n0, const float* ksc, LAS float* scr, int kb, int nb, int) {
    const int lane = lane_id();
    const int k0 = 64 * kb, n0 = 32 * nb;
    { f32x4 ld[8];
#pragma unroll
      for (int i = 0; i < 8; ++i) ld[i] = __builtin_nontemporal_load((const f32x4*)(W + (size_t)(k0 + 8 * i + (lane >> 3)) * N + n0 + 4 * (lane & 7)));
#pragma unroll
      for (int i = 0; i < 8; ++i) { LAS float* d_ = scr + (8 * i + (lane >> 3)) * 33 + 4 * (lane & 7); d_[0] = ld[i].x; d_[1] = ld[i].y; d_[2] = ld[i].z; d_[3] = ld[i].w; } }
    LDS_WAIT(); asm volatile("" ::: "memory");
    const int c = lane & 7;
    float sc[8];
#pragma unroll
    for (int q = 0; q < 8; ++q) sc[q] = ksc ? ksc[k0 + 8 * c + q] : 1.0f;
#pragma unroll
    for (int j = 0; j < 4; ++j) { const int n = (lane >> 3) + 8 * j; const LAS float* s = scr + (8 * c) * 33 + n;
        v4u o; o.x = pk2(s[0 * 33] * sc[0], s[1 * 33] * sc[1]); o.y = pk2(s[2 * 33] * sc[2], s[3 * 33] * sc[3]); o.z = pk2(s[4 * 33] * sc[4], s[5 * 33] * sc[5]); o.w = pk2(s[6 * 33] * sc[6], s[7 * 33] * sc[7]);
        *(v4u*)(WT + (size_t)(row_off_n0 + n) * K + k0 + 8 * c) = o; }
    LDS_WAIT(); asm volatile("" ::: "memory");
}
__device__ __forceinline__ void p0_transpose_item8(const float* W, int K, int N, unsigned char* WT, int row_off_n0, const float* ksc, LAS float* scr, int kb, int nb, int) {
    const int lane = lane_id();
    const int k0 = 128 * kb, n0 = 32 * nb;
    { f32x4 ld[16];
#pragma unroll
      for (int i = 0; i < 16; ++i) ld[i] = __builtin_nontemporal_load((const f32x4*)(W + (size_t)(k0 + 8 * i + (lane >> 3)) * N + n0 + 4 * (lane & 7)));
#pragma unroll
      for (int i = 0; i < 16; ++i) { const int kk = 8 * i + (lane >> 3), c = 4 * (lane & 7), x_ = kk & 31;
          scr[kk * 32 + ((c + 0) ^ x_)] = ld[i].x; scr[kk * 32 + ((c + 1) ^ x_)] = ld[i].y; scr[kk * 32 + ((c + 2) ^ x_)] = ld[i].z; scr[kk * 32 + ((c + 3) ^ x_)] = ld[i].w; } }
    LDS_WAIT(); asm volatile("" ::: "memory");
    const int c8 = lane & 7;
    float sc[16];
#pragma unroll
    for (int q = 0; q < 16; ++q) sc[q] = (ksc ? ksc[k0 + 16 * c8 + q] : 1.0f) * WSCALE;
#pragma unroll 1
    for (int j = 0; j < 4; ++j) { const int n = (lane >> 3) + 8 * j; float v[16];
#pragma unroll
        for (int q = 0; q < 16; ++q) { const int kk = 16 * c8 + q; v[q] = scr[kk * 32 + (n ^ (kk & 31))] * sc[q]; }
        unsigned w[4];
#pragma unroll
        for (int q = 0; q < 4; ++q) { int p = __builtin_amdgcn_cvt_pk_fp8_f32(v[4 * q], v[4 * q + 1], 0, false); p = __builtin_amdgcn_cvt_pk_fp8_f32(v[4 * q + 2], v[4 * q + 3], p, true); w[q] = (unsigned)p; }
        *(v4u*)(WT + (size_t)(row_off_n0 + n) * K + k0 + 16 * c8) = (v4u){w[0], w[1], w[2], w[3]}; }
    LDS_WAIT(); asm volatile("" ::: "memory");
}
__device__ __forceinline__ void p0_prologue(Frame& F) {
    LAS float* scr = (LAS float*)(F.lds + F.wave * 16384);
    const int gw = F.c * NWAVES + F.wave, NGW = F.G * NWAVES, lane = lane_id();
    constexpr int I_IN = 16 * 32, I_OUT = 16 * 32, I_R = 16 * 2, I_G = 64 * 64, I_D = 64 * 64, I_S = 64, I_F = 8 * 64;
    constexpr int NITEMS = I_IN + I_OUT + I_R + 2 * I_G + I_D + 3 * I_S + I_F;
    unsigned char* WguT = WSP(unsigned char, WS_WGU); unsigned char* WdT = WSP(unsigned char, WS_WD);
    for (int it = gw; it < NITEMS; it += NGW) {
        int r = it;
        if (r < I_IN) { p0_transpose_item(karg_in(2), 1024, 1536, WSP(bf16, WS_WIN), (r & 31) * 32, karg_in(1), scr, r >> 5, r & 31, lane); continue; } r -= I_IN;
        if (r < I_OUT) { p0_transpose_item(karg_in(9), 1024, 1024, WSP(bf16, WS_WOUT), (r % 32) * 32, nullptr, scr, r / 32, r % 32, lane); continue; } r -= I_OUT;
        if (r < I_R) { p0_transpose_item(karg_in(11), 1024, 64, WSP(bf16, WS_WR), (r % 2) * 32, karg_in(10), scr, r / 2, r % 2, lane); continue; } r -= I_R;
        if (r < 2 * I_G) { const int up = r >= I_G; if (up) r -= I_G; const int e = r >> 6, q = r & 63, kb = q >> 3, nb = q & 7, n0 = nb * 32;
            p0_transpose_item8((up ? karg_in(14) : karg_in(13)) + (size_t)e * 1024 * 256, 1024, 256, WguT + (size_t)e * 512 * 1024, (n0 >> 7) * 256 + up * 128 + (n0 & 127), karg_in(10), scr, kb, nb, lane); continue; } r -= 2 * I_G;
        if (r < I_D) { const int e = r >> 6, q = r & 63, kb = q >> 5, nb = q & 31;
            p0_transpose_item8(karg_in(15) + (size_t)e * 256 * 1024, 256, 1024, WdT + (size_t)e * 1024 * 256, nb * 32, nullptr, scr, kb, nb, lane); continue; } r -= I_D;
        if (r < 2 * I_S) { const int up = r >= I_S; if (up) r -= I_S; const int kb = r >> 3, nb = r & 7, n0 = nb * 32;
            p0_transpose_item8(up ? karg_in(17) : karg_in(16), 1024, 256, WguT + (size_t)64 * 512 * 1024, (n0 >> 7) * 256 + up * 128 + (n0 & 127), karg_in(10), scr, kb, nb, lane); continue; } r -= 2 * I_S;
        if (r < I_S) { const int kb = r >> 5, nb = r & 31; p0_transpose_item8(karg_in(18), 256, 1024, WdT + (size_t)64 * 1024 * 256, nb * 32, nullptr, scr, kb, nb, lane); continue; } r -= I_S;
        {
            const int g = r >> 6, k0 = 16 * (r & 63), n0 = 1024 + 64 * g, ln2 = lane_id();
            const float* src = karg_in(2) + (size_t)k0 * 1536 + n0 + ln2; const float* g1 = karg_in(1) + k0;
            float xv[16];
#pragma unroll
            for (int i = 0; i < 16; ++i) xv[i] = src[(size_t)i * 1536];
            { float sn, cs; sincospif((float)ln2 * (1.0f / 32.0f), &sn, &cs); scr[1024 + ln2] = cs; scr[1088 + ln2] = sn; }
#pragma unroll
            for (int p = 0; p < 4; ++p) *(LAS f32x4*)(scr + ln2 * 16 + 4 * p) = (f32x4){xv[4 * p] * g1[4 * p], xv[4 * p + 1] * g1[4 * p + 1], xv[4 * p + 2] * g1[4 * p + 2], xv[4 * p + 3] * g1[4 * p + 3]};
            LDS_WAIT(); asm volatile("" ::: "memory");
            const int mm = ln2 <= 32 ? ln2 : ln2 - 32;
            float o[16];
#pragma unroll
            for (int q = 0; q < 16; ++q) o[q] = 0.f;
#pragma unroll 8
            for (int c = 0; c < 64; ++c) { const int ix = (mm * c) & 63; const float cs = scr[1024 + ix], sn = scr[1088 + ix]; const float tmc = ln2 <= 32 ? cs : -sn;
#pragma unroll
                for (int p = 0; p < 4; ++p) { const f32x4 rv = *(const LAS f32x4*)(scr + c * 16 + 4 * p); o[4 * p] += rv.x * tmc; o[4 * p + 1] += rv.y * tmc; o[4 * p + 2] += rv.z * tmc; o[4 * p + 3] += rv.w * tmc; } }
            bf16* dst = WSP(bf16, WS_WIN) + (size_t)(n0 + ln2) * 1024 + k0;
            *(v4u*)dst = (v4u){pk2(o[0], o[1]), pk2(o[2], o[3]), pk2(o[4], o[5]), pk2(o[6], o[7])};
            *(v4u*)(dst + 8) = (v4u){pk2(o[8], o[9]), pk2(o[10], o[11]), pk2(o[12], o[13]), pk2(o[14], o[15])};
            LDS_WAIT(); asm volatile("" ::: "memory");
        }
    }
    bf16* XN = WSP(bf16, WS_XN);
    float* RSTD1 = WSP(float, WS_RSTD1);
    for (int m0 = gw * 2; m0 < T; m0 += NGW * 2) {
        f32x4 v[2][4];
#pragma unroll
        for (int r = 0; r < 2; ++r) { const f32x4* xr = (const f32x4*)(karg_in(0) + (size_t)(m0 + r) * D) + lane;
#pragma unroll
            for (int j = 0; j < 4; ++j) v[r][j] = __builtin_nontemporal_load(xr + 64 * j); }
#pragma unroll
        for (int r = 0; r < 2; ++r) { float sq = 0.f; unsigned long long* o8 = (unsigned long long*)(XN + (size_t)(m0 + r) * D) + lane;
#pragma unroll
            for (int j = 0; j < 4; ++j) { sq += (v[r][j].x * v[r][j].x + v[r][j].y * v[r][j].y) + (v[r][j].z * v[r][j].z + v[r][j].w * v[r][j].w);
                o8[64 * j] = (unsigned long long)pk2(v[r][j].x, v[r][j].y) | ((unsigned long long)pk2(v[r][j].z, v[r][j].w) << 32); }
            const float rstd = 1.0f / sqrtf(wave_sum(sq) * (1.f / D) + EPS);
            if (lane == 0) RSTD1[m0 + r] = rstd; }
    }
    const int gt = F.c * 512 + (F.wave * 64 + lane_id()), NGT = F.G * 512;
    bf16* WSB = WSP(bf16, WS_WSB);
    for (int i = gt; i < 8 * 128 * 128; i += NGT) WSB[i] = (bf16)f2bf(karg_in(5)[i]);
    { unsigned char* IMG = WSP(unsigned char, WS_F2IMG);
      for (int i = gt; i < 128 * 128 + 64 * 128 + 2048; i += NGT) {
        if (i < 128 * 128) { const int r = i >> 7, c = i & 127, pp = r >> 6, k1 = r & 63, p = c >> 6, s1 = c & 63; float sn, cs; sincospif((float)((k1 * s1) & 63) * (1.0f / 32.0f), &sn, &cs);
            const float v = pp == 0 ? (p == 0 ? cs : sn) : (p == 0 ? -sn : cs); *(bf16*)(IMG + FB_OFF + r * FPITCH + c * 2) = (bf16)f2bf(v); }
        else if (i < 128 * 128 + 64 * 128) { const int j = i - 128 * 128, k2 = j >> 7, c = j & 127, p = c >> 6, s2 = c & 63; float sn, cs; sincospif((float)((k2 * s2) & 63) * (1.0f / 32.0f), &sn, &cs);
            *(bf16*)(IMG + GT_OFF + k2 * FPITCH + c * 2) = (bf16)f2bf(p == 0 ? cs : sn); }
        else { const int j = i - 128 * 128 - 64 * 128; float sn, cs; sincospif((float)j * (2.0f / 4096.0f), &sn, &cs); *(f32x2*)(IMG + TWL_OFF + j * 8) = (f32x2){cs, -sn}; } } }
    { bf16* CF = WSP(bf16, WS_CF);
      for (int i = gt; i < 64 * 2 * 512; i += NGT) { const int bg = i >> 10, m = ((i >> 9) & 1) * 32, o = i & 511; *(v4u*)(CF + ((size_t)(bg * 33 + m) * 2 + 1) * 4096 + o * 8) = (v4u){0u, 0u, 0u, 0u}; } }
    f32x2* TW = WSP(f32x2, WS_TW);
    for (int i = gt; i < 2048 + 64; i += NGT) {
        if (i < 2048) { float s, c; sincospif((float)i * (2.0f / 4096.0f), &s, &c); TW[i] = (f32x2){c, -s}; }
        else { const int j = i - 2048; float s, c; sincospif((float)j * (2.0f / 64.0f), &s, &c); TW[2048 + j] = (f32x2){c, s}; }
    }
}

constexpr int VN_PITCH = 272;
__host__ __device__ __forceinline__ int sgu_row(int c) { return 16 * (2 * (c >> 5) + ((c >> 2) & 1)) + 4 * ((c >> 3) & 3) + (c & 3); }
__device__ __forceinline__ void sgu_item(Frame& F, int item) {
    const int t0 = item * 128, lane = lane_id(), h = F.wave, fr = lane & 15, fq = lane >> 4;
    const bf16* Z = WSP(const bf16, WS_Z) + (size_t)t0 * DIN;
    LAS unsigned char* vnT = F.lds;
    LAS float* ssq = (LAS float*)(F.lds + 512 * VN_PITCH + 1024);
    { v4u wv[16];
#pragma unroll
      for (int r = 0; r < 16; ++r) wv[r] = __builtin_nontemporal_load((const v4u*)(Z + (size_t)(16 * h + r) * DIN + 512 + lane * 8));
      float gch[8], bch[8];
      { const f32x4 ga = *(const f32x4*)(karg_in(3) + lane * 8), gb = *(const f32x4*)(karg_in(3) + lane * 8 + 4), ba = *(const f32x4*)(karg_in(4) + lane * 8), bb = *(const f32x4*)(karg_in(4) + lane * 8 + 4);
        gch[0] = ga.x; gch[1] = ga.y; gch[2] = ga.z; gch[3] = ga.w; gch[4] = gb.x; gch[5] = gb.y; gch[6] = gb.z; gch[7] = gb.w;
        bch[0] = ba.x; bch[1] = ba.y; bch[2] = ba.z; bch[3] = ba.w; bch[4] = bb.x; bch[5] = bb.y; bch[6] = bb.z; bch[7] = bb.w; }
#pragma unroll
      for (int rb = 0; rb < 2; ++rb) { unsigned o[8][4];
#pragma unroll
        for (int rr = 0; rr < 8; ++rr) { const v4u w = wv[rb * 8 + rr];
            float v[8] = {bflo(w.x), bfhi(w.x), bflo(w.y), bfhi(w.y), bflo(w.z), bfhi(w.z), bflo(w.w), bfhi(w.w)}; float s1 = 0.f;
#pragma unroll
            for (int j = 0; j < 8; ++j) s1 += v[j];
            const float mean = wave_sum(s1) * (1.f / 512.f); float s2 = 0.f;
#pragma unroll
            for (int j = 0; j < 8; ++j) { v[j] -= mean; s2 += v[j] * v[j]; }
            const float rstd = 1.0f / sqrtf(wave_sum(s2) * (1.f / 512.f) + EPS);
#pragma unroll
            for (int j = 0; j < 8; ++j) { const unsigned bits = f2bf(v[j] * rstd * gch[j] + bch[j]); if (rr & 1) o[j][rr >> 1] |= bits << 16; else o[j][rr >> 1] = bits; } }
        const int hh = lane >> 3, cl = (lane & 7) * 8;
#pragma unroll
        for (int j = 0; j < 8; ++j) *(LAS v4u*)(vnT + (hh * 64 + sgu_row(cl + j)) * VN_PITCH + (16 * h + rb * 8) * 2) = (v4u){o[j][0], o[j][1], o[j][2], o[j][3]}; } }
    LDS_BARRIER();
    const bf16* WSB = WSP(const bf16, WS_WSB) + (size_t)h * 128 * 128;
    bf16* MIX = WSP(bf16, WS_MIX) + (size_t)t0 * D;
    bf16x8 Xf[4][4];
#pragma unroll
    for (int ks = 0; ks < 4; ++ks)
#pragma unroll
        for (int dt = 0; dt < 4; ++dt) Xf[ks][dt] = *(const LAS bf16x8*)(vnT + (h * 64 + dt * 16 + fr) * VN_PITCH + (ks * 32 + fq * 8) * 2);
    unsigned ypk[8][8];
    bf16x8 Yc[4], Yn[4]; v4u uc[2], un[2];
#pragma unroll
    for (int ks = 0; ks < 4; ++ks) Yc[ks] = *(const bf16x8*)(WSB + (size_t)fr * 128 + ks * 32 + fq * 8);
#pragma unroll
    for (int t = 0; t < 2; ++t) uc[t] = __builtin_nontemporal_load((const v4u*)(Z + (size_t)fr * DIN + h * 64 + 32 * t + 8 * fq));
#pragma unroll
    for (int pt = 0; pt < 8; ++pt) {
        if (pt < 7) {
#pragma unroll
            for (int ks = 0; ks < 4; ++ks) Yn[ks] = *(const bf16x8*)(WSB + (size_t)((pt + 1) * 16 + fr) * 128 + ks * 32 + fq * 8);
#pragma unroll
            for (int t = 0; t < 2; ++t) un[t] = __builtin_nontemporal_load((const v4u*)(Z + (size_t)((pt + 1) * 16 + fr) * DIN + h * 64 + 32 * t + 8 * fq)); }
        f32x4 acc[4];
#pragma unroll
        for (int dt = 0; dt < 4; ++dt) acc[dt] = (f32x4){0.f, 0.f, 0.f, 0.f};
#pragma unroll
        for (int ks = 0; ks < 4; ++ks) {
#pragma unroll
            for (int dt = 0; dt < 4; ++dt) acc[dt] = __builtin_amdgcn_mfma_f32_16x16x32_bf16(Xf[ks][dt], Yc[ks], acc[dt], 0, 0, 0); }
        const int p = pt * 16 + fr; const float bias = karg_in(6)[h * 128 + p]; float ss = 0.f;
#pragma unroll
        for (int t = 0; t < 2; ++t) { const v4u uw = uc[t]; const f32x4 a0 = acc[2 * t], a1 = acc[2 * t + 1];
            const float y0 = bflo(uw.x) * (a0[0] + bias), y1 = bfhi(uw.x) * (a0[1] + bias), y2 = bflo(uw.y) * (a0[2] + bias), y3 = bfhi(uw.y) * (a0[3] + bias);
            const float y4 = bflo(uw.z) * (a1[0] + bias), y5 = bfhi(uw.z) * (a1[1] + bias), y6 = bflo(uw.w) * (a1[2] + bias), y7 = bfhi(uw.w) * (a1[3] + bias);
            ss += ((y0 * y0 + y1 * y1) + (y2 * y2 + y3 * y3)) + ((y4 * y4 + y5 * y5) + (y6 * y6 + y7 * y7));
            ypk[pt][4 * t + 0] = pk2(y0, y1); ypk[pt][4 * t + 1] = pk2(y2, y3); ypk[pt][4 * t + 2] = pk2(y4, y5); ypk[pt][4 * t + 3] = pk2(y6, y7); }
        ss = xor32_sum(xor16_sum(ss)); if (fq == 0) ssq[p * 8 + h] = ss;
        __builtin_amdgcn_sched_barrier(0);
#pragma unroll
        for (int ks = 0; ks < 4; ++ks) Yc[ks] = Yn[ks];
        uc[0] = un[0]; uc[1] = un[1];
    }
    LDS_BARRIER();
#pragma unroll
    for (int pt = 0; pt < 8; ++pt) { const int p = pt * 16 + fr; float tot = 0.f;
#pragma unroll
        for (int j = 0; j < 8; ++j) tot += ssq[p * 8 + j];
        const float rstd = 1.0f / sqrtf(tot * (1.f / 512.f) + EPS);
#pragma unroll
        for (int t = 0; t < 2; ++t) { const int ch = h * 64 + 32 * t + 8 * fq; const f32x4 g0 = *(const f32x4*)(karg_in(7) + ch), g1 = *(const f32x4*)(karg_in(7) + ch + 4);
            const unsigned w0 = ypk[pt][4 * t], w1 = ypk[pt][4 * t + 1], w2 = ypk[pt][4 * t + 2], w3 = ypk[pt][4 * t + 3];
            *(v4u*)(MIX + (size_t)p * D + ch) = (v4u){pk2(bflo(w0) * rstd * g0.x, bfhi(w0) * rstd * g0.y), pk2(bflo(w1) * rstd * g0.z, bfhi(w1) * rstd * g0.w),
                                                     pk2(bflo(w2) * rstd * g1.x, bfhi(w2) * rstd * g1.y), pk2(bflo(w3) * rstd * g1.z, bfhi(w3) * rstd * g1.w)}; } }
    LDS_BARRIER();
}
__device__ __forceinline__ void f1_item(Frame& F, int item) {
    const int t0 = item * 64, b = t0 >> 12, s0 = t0 & 4095, tid = (F.wave * 64 + lane_id()), lane = lane_id(), g = F.wave;
    const bf16* Z = WSP(const bf16, WS_Z) + (size_t)t0 * DIN + 1024;
    LAS float* zt = (LAS float*)F.lds;
#pragma unroll
    for (int i = 0; i < 8; ++i) { const int idx = tid + 512 * i, tok = idx >> 6, c8 = idx & 63; const v4u w = __builtin_nontemporal_load((const v4u*)(Z + (size_t)tok * DIN + c8 * 8)); LAS float* d = zt + tok * 513 + c8 * 8;
        d[0] = bflo(w.x); d[1] = bfhi(w.x); d[2] = bflo(w.y); d[3] = bfhi(w.y); d[4] = bflo(w.z); d[5] = bfhi(w.z); d[6] = bflo(w.w); d[7] = bfhi(w.w); }
    LDS_BARRIER();
    bf16* CF = WSP(bf16, WS_CF) + ((size_t)(b * 8 + g) * 33) * 8192 + s0 + lane;
    const LAS float* zr = zt + lane * 513 + g * 64;
#pragma unroll
    for (int m = 0; m <= 32; ++m) { const float re = zr[m], im = (m >= 1 && m <= 31) ? zr[32 + m] : 0.f; CF[(size_t)m * 8192] = (bf16)f2bf(re); CF[(size_t)m * 8192 + 4096] = (bf16)f2bf(im); }
    LDS_BARRIER();
}
typedef short s16x4 __attribute__((ext_vector_type(4)));
__device__ __forceinline__ void f2_phase(Frame& F) {
    LAS unsigned char* L = F.lds; const int tid = (F.wave * 64 + lane_id()), lane = lane_id(), wave = F.wave, l15 = lane & 15, kg = lane >> 4;
    { const v4u* IMG = WSP(const v4u, WS_F2IMG); for (int i = tid; i < XI_OFF / 16; i += 512) *(LAS v4u*)(L + i * 16) = IMG[i]; }
    const LAS f32x2* TWL = (const LAS f32x2*)(L + TWL_OFF);
    const bf16* CF = WSP(const bf16, WS_CF);
    int col = F.c; v4u pre[2];
    if (col < NCOLF) { pre[0] = __builtin_nontemporal_load((const v4u*)(CF + (size_t)col * 8192 + tid * 8)); pre[1] = __builtin_nontemporal_load((const v4u*)(CF + (size_t)col * 8192 + 4096 + tid * 8)); }
    LDS_BARRIER();
    const int mt = wave & 3, pg = wave >> 2;
    for (int buf = 0; col < NCOLF; col += F.G, buf ^= 1) {
        LAS unsigned char* XI = L + XI_OFF + buf * XI_SZ;
        *(LAS v4u*)(XI + (tid >> 3) * XPITCH + (tid & 7) * 16) = pre[0]; *(LAS v4u*)(XI + (64 + (tid >> 3)) * XPITCH + (tid & 7) * 16) = pre[1];
        if (col + F.G < NCOLF) { pre[0] = __builtin_nontemporal_load((const v4u*)(CF + (size_t)(col + F.G) * 8192 + tid * 8)); pre[1] = __builtin_nontemporal_load((const v4u*)(CF + (size_t)(col + F.G) * 8192 + 4096 + tid * 8)); }
        LDS_BARRIER();
        f32x4 acc[2][2];
#pragma unroll
        for (int a_ = 0; a_ < 2; ++a_)
#pragma unroll
            for (int b_ = 0; b_ < 2; ++b_) acc[a_][b_] = (f32x4){0.f, 0.f, 0.f, 0.f};
#pragma unroll
        for (int ks = 0; ks < 4; ++ks) {
            const int rowb = ks * 32 + 8 * kg + (l15 >> 2), colb = 16 * mt + 4 * (lane & 3);
            const s16x4 alo = __builtin_amdgcn_ds_read_tr16_b64_v4i16((LAS s16x4*)(XI + rowb * XPITCH + colb * 2));
            const s16x4 ahi = __builtin_amdgcn_ds_read_tr16_b64_v4i16((LAS s16x4*)(XI + (rowb + 4) * XPITCH + colb * 2));
            const bf16x8 A = __builtin_shufflevector(alo, ahi, 0, 1, 2, 3, 4, 5, 6, 7);
#pragma unroll
            for (int kt = 0; kt < 2; ++kt)
#pragma unroll
                for (int part = 0; part < 2; ++part) { const int jrow = part * 64 + (2 * pg + kt) * 16 + l15;
                    const bf16x8 B = *(const LAS bf16x8*)(L + FB_OFF + jrow * FPITCH + (ks * 32 + 8 * kg) * 2);
                    acc[kt][part] = __builtin_amdgcn_mfma_f32_16x16x32_bf16(A, B, acc[kt][part], 0, 0, 0); }
        }
#pragma unroll
        for (int kt = 0; kt < 2; ++kt) { const int k1 = (2 * pg + kt) * 16 + l15, s2b = 16 * mt + 4 * kg; float tr4[4], ti4[4];
#pragma unroll
            for (int r = 0; r < 4; ++r) { const int idx = k1 * (s2b + r); f32x2 w = TWL[idx & 2047]; if (idx >= 2048) w = -w;
                const float tr = acc[kt][0][r], ti = acc[kt][1][r]; tr4[r] = tr * w.x - ti * w.y; ti4[r] = tr * w.y + ti * w.x; }
            *(LAS v2u*)(L + TI_OFF + k1 * FPITCH + s2b * 2) = (v2u){pk2(tr4[0], tr4[1]), pk2(tr4[2], tr4[3])};
            *(LAS v2u*)(L + TI_OFF + k1 * FPITCH + (64 + s2b) * 2) = (v2u){pk2(ti4[0], ti4[1]), pk2(ti4[2], ti4[3])}; }
        LDS_BARRIER();
        f32x4 acc2[2] = {(f32x4){0.f, 0.f, 0.f, 0.f}, (f32x4){0.f, 0.f, 0.f, 0.f}};
#pragma unroll
        for (int ks = 0; ks < 4; ++ks) { const bf16x8 G2 = *(const LAS bf16x8*)(L + GT_OFF + (16 * mt + l15) * FPITCH + (ks * 32 + 8 * kg) * 2);
#pragma unroll
            for (int j = 0; j < 2; ++j) { const bf16x8 T2 = *(const LAS bf16x8*)(L + TI_OFF + ((2 * pg + j) * 16 + l15) * FPITCH + (ks * 32 + 8 * kg) * 2);
                acc2[j] = __builtin_amdgcn_mfma_f32_16x16x32_bf16(T2, G2, acc2[j], 0, 0, 0); } }
        float* dst = WSP(float, WS_YT) + (size_t)col * 4096;
#pragma unroll
        for (int j = 0; j < 2; ++j) *(f32x4*)(dst + (16 * mt + l15) * 64 + (2 * pg + j) * 16 + 4 * kg) = acc2[j] * (1.0f / 512.0f);
    }
    LDS_BARRIER();
}
__device__ __forceinline__ void f3_item(Frame& F, int item) {
    const int t0 = item * 64, b = t0 >> 12, k0 = t0 & 4095, lane = lane_id(), g = F.wave;
    LAS float* yt = (LAS float*)F.lds;
    const float* YT = WSP(const float, WS_YT) + ((size_t)(b * 8 + g) * 33) * 4096;
    { const int tq = lane & 15, cs = lane >> 4;
#pragma unroll
      for (int mb = 0; mb < 36; mb += 12) { f32x4 v[3], v2[3];
#pragma unroll
        for (int i = 0; i < 3; ++i) { const int m = mb + 4 * i + cs;
            const int mc = m <= 32 ? m : 32;
            v[i] = __builtin_nontemporal_load((const f32x4*)(YT + (size_t)mc * 4096 + k0 + 4 * tq));
            const int kb = 4096 - k0 - 4 * tq - 3;
            if (k0 + tq != 0) v2[i] = __builtin_nontemporal_load((const f32x4*)(YT + (size_t)mc * 4096 + kb));
            else { const float* yp = YT + (size_t)mc * 4096; v2[i] = (f32x4){yp[4093], yp[4094], yp[4095], yp[0]}; } }
#pragma unroll
        for (int i = 0; i < 3; ++i) { const int m = mb + 4 * i + cs;
            if (m <= 32) { LAS float* d_ = yt + (4 * tq) * 513 + g * 64 + m; d_[0] = v[i].x; d_[513] = v[i].y; d_[2 * 513] = v[i].z; d_[3 * 513] = v[i].w;
                if (m >= 1 && m <= 31) { LAS float* e_ = yt + (4 * tq) * 513 + g * 64 + 64 - m; e_[0] = v2[i].w; e_[513] = v2[i].z; e_[2 * 513] = v2[i].y; e_[3 * 513] = v2[i].x; } } } } }
    LDS_BARRIER();
    bf16* MIX = WSP(bf16, WS_MIX) + (size_t)t0 * D + 512;
    for (int r = 0; r < 8; ++r) { const int row = F.wave * 8 + r; float ss = 0.f;
#pragma unroll
        for (int j = 0; j < 8; ++j) { const float v = yt[row * 513 + lane + 64 * j]; ss += v * v; }
        const float rstd = 1.0f / sqrtf(wave_sum(ss) * (1.f / 512.f) + EPS);
        float v[8];
#pragma unroll
        for (int j = 0; j < 8; ++j) v[j] = yt[row * 513 + lane * 8 + j] * rstd * karg_in(8)[lane * 8 + j];
        *(v4u*)(MIX + (size_t)row * D + lane * 8) = (v4u){pk2(v[0], v[1]), pk2(v[2], v[3]), pk2(v[4], v[5]), pk2(v[6], v[7])}; }
    LDS_BARRIER();
}

constexpr int WR_PITCH = 2064;
__device__ __forceinline__ float red16_max(float v) { v = fmaxf(v, dpp_f<0xB1>(v)); v = fmaxf(v, dpp_f<0x4E>(v)); v = fmaxf(v, dpp_f<0x141>(v)); v = fmaxf(v, dpp_f<0x140>(v)); return v; }
__device__ __forceinline__ int red16_min(int v) { v = min(v, dpp_i<0xB1>(v)); v = min(v, dpp_i<0x4E>(v)); v = min(v, dpp_i<0x141>(v)); v = min(v, dpp_i<0x140>(v)); return v; }
__device__ __forceinline__ float red8_max(float v) { v = fmaxf(v, dpp_f<0xB1>(v)); v = fmaxf(v, dpp_f<0x4E>(v)); v = fmaxf(v, dpp_f<0x141>(v)); return v; }
__device__ __forceinline__ int red8_min(int v) { v = min(v, dpp_i<0xB1>(v)); v = min(v, dpp_i<0x4E>(v)); v = min(v, dpp_i<0x141>(v)); return v; }
__device__ __forceinline__ float red16_sum(float v) { return row16_sum(v); }
__device__ __forceinline__ void route_phase(Frame& F) {
    const int tid = (F.wave * 64 + lane_id()), lane = lane_id(), wave = F.wave, c16 = lane & 15, rg = lane >> 4;
    LAS unsigned char* wr = F.lds;
    LAS int* lcnt = (LAS int*)(F.lds + 64 * WR_PITCH);
    LAS int* gbase = lcnt + 64;
    const bf16* WR = WSP(const bf16, WS_WR);
    for (int i = tid; i < 64 * 128; i += 512) { const int e = i >> 7, ch = i & 127; *(LAS v4u*)(wr + e * WR_PITCH + ch * 16) = *(const v4u*)(WR + (size_t)e * 1024 + ch * 8); }
    LDS_BARRIER();
    const bf16* HB = WSP(const bf16, WS_HB); const float* SSP = WSP(const float, WS_SSP);
    float* RSTD2 = WSP(float, WS_RSTD2); float* RSL = WSP(float, WS_RSL); float* GL = WSP(float, WS_GL); int* LIST = WSP(int, WS_LIST); unsigned short* TOKP = WSP(unsigned short, WS_TOKP); unsigned* GCNT = F.ctl + CW_CNT;
    float bias[4];
#pragma unroll
    for (int nt = 0; nt < 4; ++nt) bias[nt] = karg_in(12)[nt * 16 + c16];
    for (int item = F.c; item < T / 128; item += F.G) {
        const int t0 = item * 128 + wave * 16;
        if (tid < 64) lcnt[tid] = 0;
        f32x4 acc[4];
#pragma unroll
        for (int nt = 0; nt < 4; ++nt) acc[nt] = (f32x4){0.f, 0.f, 0.f, 0.f};
        const bf16* arow = HB + (size_t)(t0 + c16) * D + rg * 8;
        v4u a_all[8][4];
#pragma unroll
        for (int blk = 0; blk < 8; ++blk)
#pragma unroll
            for (int s = 0; s < 4; ++s) a_all[blk][s] = __builtin_nontemporal_load((const v4u*)(arow + blk * 128 + s * 32));
#pragma unroll
        for (int blk = 0; blk < 8; ++blk) {
#pragma unroll
            for (int s = 0; s < 4; ++s) { const bf16x8 Af = __builtin_bit_cast(bf16x8, a_all[blk][s]);
#pragma unroll
                for (int nt = 0; nt < 4; ++nt) { const bf16x8 Bf = *(const LAS bf16x8*)(wr + (nt * 16 + c16) * WR_PITCH + (blk * 128 + s * 32 + rg * 8) * 2);
                    acc[nt] = __builtin_amdgcn_mfma_f32_16x16x32_bf16(Af, Bf, acc[nt], 0, 0, 0); } }
        }
        LDS_BARRIER();
        int sel_lpos[4][4]; int sel_k[4][4]; float sel_w[4][4]; float sel_rs[4];
#pragma unroll
        for (int r = 0; r < 4; ++r) {
            const int tok = t0 + 4 * rg + r;
            float part = SSP[(size_t)tok * 16 + c16]; part = red16_sum(part);
            const float rs = 1.0f / sqrtf(part * (1.f / D) + EPS);
            if (c16 == 0) RSTD2[tok] = rs;
            sel_rs[r] = rs;
            float sc[4], bv[4];
#pragma unroll
            for (int nt = 0; nt < 4; ++nt) { const float lg = acc[nt][r] * rs; sc[nt] = 1.0f / (1.0f + __expf(-lg)); bv[nt] = sc[nt] + bias[nt]; }
            float gs[4];
#pragma unroll
            for (int nt = 0; nt < 4; ++nt) { const float m1 = red8_max(bv[nt]); const int i1 = red8_min(bv[nt] == m1 ? (c16 & 7) : 99); const float v2 = ((c16 & 7) == i1) ? -INFINITY : bv[nt]; gs[nt] = m1 + red8_max(v2); }
            float G8[8];
#pragma unroll
            for (int nt = 0; nt < 4; ++nt) { const float og = dpp_f<0x140>(gs[nt]);     G8[2 * nt] = (c16 < 8) ? gs[nt] : og; G8[2 * nt + 1] = (c16 < 8) ? og : gs[nt]; }
            bool gsel[8];
#pragma unroll
            for (int j = 0; j < 8; ++j) { int rank = 0;
#pragma unroll
                for (int i = 0; i < 8; ++i) if (i != j) rank += (G8[i] > G8[j] || (G8[i] == G8[j] && i < j)) ? 1 : 0;
                gsel[j] = rank < 4; }
            float mv[4];
#pragma unroll
            for (int nt = 0; nt < 4; ++nt) { const bool s_ = (c16 < 8) ? gsel[2 * nt] : gsel[2 * nt + 1]; mv[nt] = s_ ? bv[nt] : -INFINITY; }
            bool picked[4] = {false, false, false, false}; int pk_k[4] = {0, 0, 0, 0}; float wsum = 0.f;
#pragma unroll
            for (int k = 0; k < 8; ++k) {
                float lm = fmaxf(fmaxf(mv[0], mv[1]), fmaxf(mv[2], mv[3])); const float gm = red16_max(lm);
                int li = 999;
#pragma unroll
                for (int nt = 3; nt >= 0; --nt) if (mv[nt] == gm) li = nt * 16 + c16;
                const int gi = red16_min(li);
#pragma unroll
                for (int nt = 0; nt < 4; ++nt) if (gi == nt * 16 + c16) { picked[nt] = true; pk_k[nt] = k; mv[nt] = -INFINITY; wsum += sc[nt]; }
            }
            wsum = red16_sum(wsum);
            const float wn = 2.5f / wsum;
#pragma unroll
            for (int nt = 0; nt < 4; ++nt) { sel_lpos[r][nt] = -1; sel_k[r][nt] = pk_k[nt]; sel_w[r][nt] = sc[nt] * wn;
                if (picked[nt]) sel_lpos[r][nt] = __hip_atomic_fetch_add(&lcnt[nt * 16 + c16], 1, __ATOMIC_RELAXED, __HIP_MEMORY_SCOPE_WORKGROUP); }
        }
        LDS_BARRIER();
        if (tid < 64) gbase[tid] = (int)atomicAdd(&GCNT[tid], (unsigned)lcnt[tid]);
        LDS_BARRIER();
        LAS int* ent = (LAS int*)(F.lds + 64 * WR_PITCH + 1024);
#pragma unroll
        for (int r = 0; r < 4; ++r) { const int tl = wave * 16 + 4 * rg + r, tok = item * 128 + tl;
#pragma unroll
            for (int nt = 0; nt < 4; ++nt) if (sel_lpos[r][nt] >= 0) { const int e = nt * 16 + c16, k = sel_k[r][nt], slot = tok * 8 + k, ix = (tl * 8 + k) * 3;
                ent[ix] = e * 32768 + gbase[e] + sel_lpos[r][nt]; ent[ix + 1] = (int)(((unsigned)slot << 14) | (unsigned)(sel_w[r][nt] * (16383.0f / 2.5f) + 0.5f)); ent[ix + 2] = __builtin_bit_cast(int, sel_rs[r]); } }
        LDS_BARRIER();
#pragma unroll
        for (int i = 0; i < 2; ++i) { const int ei = tid + 512 * i, pos = ent[ei * 3], pl = pos & 32767, rr = pl & 127, tok = item * 128 + (ei >> 3);
            LIST[pos] = ent[ei * 3 + 1]; RSL[pos] = __builtin_bit_cast(float, ent[ei * 3 + 2]);
            TOKP[(pos & ~32767) + (pl & ~127) + (rr & 63) * 2 + (rr >> 6)] = (unsigned short)tok; }
        LDS_BARRIER();
    }
}

__device__ __forceinline__ void build_bst(Frame& F, volatile LAS int* bst) {
    if (F.wave == 0) { const unsigned* cnt = F.ctl + CW_CNT; const int lane = lane_id(); const int nb = ((int)cnt[lane] + 255) >> 8; int s = nb;
#pragma unroll
        for (int o = 1; o < 64; o <<= 1) { const int t = __shfl_up(s, o); if (lane >= o) s += t; }
        bst[lane] = s - nb; bst[66 + lane] = (int)cnt[lane]; if (lane == 63) { bst[64] = s; bst[65] = s + T / 256; bst[66 + 64] = T; } }
    __syncthreads();
}

using pg8::v8i32; using pg8::v8u32;
__host__ __device__ __forceinline__ int dn_perm(int rho) { const int nt = rho >> 4, q = (rho >> 2) & 3, j = rho & 3; return ((nt >> 2) << 6) + 16 * q + 4 * (nt & 3) + j; }
struct DnSeg { int blk, c_lo, c_hi; };
__device__ __forceinline__ void down_phase(Frame& F, const volatile LAS int* bst) {
    const int lane = lane_id(), w = F.wave, fr = lane & 15, fq = lane >> 4, tid = w * 64 + lane;
    LAS unsigned char* L = F.lds;
    const unsigned char* Wd = WSP(const unsigned char, WS_WD); const unsigned char* HA = (const unsigned char*)F.out;
    const unsigned* LISTP = WSP(const unsigned, WS_LIST);
    unsigned char* CT = WSP(unsigned char, WS_CONTRIB); unsigned char* C9 = WSP(unsigned char, WS_CONTRIB9); unsigned char* TR = WSP(unsigned char, WS_TRASH);
    const int NBt = bst[65], Q = (NBt + 7) >> 3, x = F.c & 7, jj = F.c >> 3, per = F.G >> 3;
    int Qx = NBt - x * Q; Qx = Qx > Q ? Q : Qx; Qx = Qx < 0 ? 0 : Qx;
    const int NFULL = Qx / per, TB = Qx - NFULL * per, tlo = (8 * TB * jj) / per, thi = (8 * TB * (jj + 1)) / per;
    const int NS = NFULL + (thi > tlo ? (((thi - 1) >> 3) - (tlo >> 3) + 1) : 0);
    if (NS == 0) return;
    auto seg = [&](int k) -> DnSeg { DnSeg sgm;
        if (k < NFULL) { sgm.blk = x * Q + k * per + jj; sgm.c_lo = 0; sgm.c_hi = 8; return sgm; }
        const int p = k - NFULL, tb = (tlo >> 3) + p, st = p == 0 ? tlo : 8 * tb, en = thi < 8 * (tb + 1) ? thi : 8 * (tb + 1);
        sgm.blk = x * Q + NFULL * per + tb; sgm.c_lo = st - 8 * tb; sgm.c_hi = en - 8 * tb; return sgm; };
    unsigned voff[4];
#pragma unroll
    for (int i = 0; i < 4; ++i) { const int s_ = i * 512 + tid, rho = s_ >> 4, p = s_ & 15; voff[i] = (unsigned)(dn_perm(rho) * 256 + ((p ^ (rho & 15)) << 4)); }
#define DN_STAGE(slot_, e_, c_) do { const unsigned char* gb_ = Wd + ((size_t)(e_) * 1024 + 128 * (c_)) * 256; _Pragma("unroll") for (int i_ = 0; i_ < 4; ++i_) \
        __builtin_amdgcn_global_load_lds((const unsigned*)(gb_ + voff[i_]), (LAS unsigned*)(L + (slot_) * 32768 + i_ * 8192 + w * 1024), 16, 0, 0); } while (0)
#define DN_WAIT4() asm volatile("s_waitcnt vmcnt(4)" ::: "memory")
#define DN_BAR() do { asm volatile("s_waitcnt lgkmcnt(0)" ::: "memory"); __builtin_amdgcn_s_barrier(); asm volatile("" ::: "memory"); } while (0)
    const int boffs0 = fr * 256 + (((2 * fq) ^ fr) << 4), boffs1 = fr * 256 + (((2 * fq + 1) ^ fr) << 4), boffs2 = fr * 256 + (((8 + 2 * fq) ^ fr) << 4), boffs3 = fr * 256 + (((8 + 2 * fq + 1) ^ fr) << 4);
#define DN_LDB(D0, D1, sb_, nt_) do { D0 = __builtin_bit_cast(v8i32, (v8u32)__builtin_shufflevector(*(const LAS v4u*)((sb_) + (nt_) * 4096 + boffs0), *(const LAS v4u*)((sb_) + (nt_) * 4096 + boffs1), 0, 1, 2, 3, 4, 5, 6, 7)); \
        D1 = __builtin_bit_cast(v8i32, (v8u32)__builtin_shufflevector(*(const LAS v4u*)((sb_) + (nt_) * 4096 + boffs2), *(const LAS v4u*)((sb_) + (nt_) * 4096 + boffs3), 0, 1, 2, 3, 4, 5, 6, 7)); } while (0)
#define DN_COMPUTE(ACC, slot_) do { const LAS unsigned char* sb_ = L + (slot_) * 32768; v8i32 bc0_, bc1_, bn0_, bn1_; DN_LDB(bc0_, bc1_, sb_, 0); \
        _Pragma("unroll") for (int nt = 0; nt < 8; ++nt) { \
            if (nt < 7) DN_LDB(bn0_, bn1_, sb_, nt + 1); \
            _Pragma("unroll") for (int mt = 0; mt < 2; ++mt) { \
                ACC[mt][nt] = __builtin_amdgcn_mfma_scale_f32_16x16x128_f8f6f4(bc0_, Af[mt][0], (f32x4){0.f, 0.f, 0.f, 0.f}, 0, 0, 0, 0x79797979, 0, 0x7C7C7C7C); \
                ACC[mt][nt] = __builtin_amdgcn_mfma_scale_f32_16x16x128_f8f6f4(bc1_, Af[mt][1], ACC[mt][nt], 0, 0, 0, 0x79797979, 0, 0x7C7C7C7C); } \
            __builtin_amdgcn_sched_barrier(0); bc0_ = bn0_; bc1_ = bn1_; } \
        _Pragma("unroll") for (int nt = 0; nt < 8; ++nt) { asm volatile("" : "+v"(ACC[0][nt]), "+v"(ACC[1][nt])); } } while (0)
#define DN_EPI(ACC, pc_) do { _Pragma("unroll") for (int mt = 0; mt < 2; ++mt) { const int r_ = 32 * w + 16 * mt + fr; const unsigned wd_ = pe_sgp[mt]; const bool routed_ = pe_e < 64; \
        const float gs_ = routed_ ? (float)(wd_ & 16383u) * (2.5f * CSCALE / 16383.0f) : CSCALE; \
        unsigned char* cp_ = routed_ ? CT + (size_t)(wd_ >> 14) * 1024 : C9 + (size_t)(pe_rb * 256 + r_) * 1024; cp_ = (r_ < pe_nv) ? cp_ : TR; cp_ += (pc_) * 128 + 16 * fq; \
        _Pragma("unroll") for (int hh = 0; hh < 2; ++hh) { unsigned wq_[4]; \
            _Pragma("unroll") for (int q = 0; q < 4; ++q) { const f32x4 v_ = ACC[mt][4 * hh + q] * gs_; int p_ = __builtin_amdgcn_cvt_pk_fp8_f32(v_[0], v_[1], 0, false); p_ = __builtin_amdgcn_cvt_pk_fp8_f32(v_[2], v_[3], p_, true); wq_[q] = (unsigned)p_; } \
            *(v4u*)(cp_ + 64 * hh) = (v4u){wq_[0], wq_[1], wq_[2], wq_[3]}; } } } while (0)
#define DN_LOADA(DST, SG, blk_, e_, rb_) do { _Pragma("unroll") for (int mt = 0; mt < 2; ++mt) { const int r_ = 32 * w + 16 * mt + fr; const unsigned char* ap_ = HA + ((size_t)(blk_) * 256 + r_) * 256 + 32 * fq; \
        _Pragma("unroll") for (int ks = 0; ks < 2; ++ks) DST[mt][ks] = __builtin_bit_cast(v8i32, (v8u32)__builtin_shufflevector(__builtin_nontemporal_load((const v4u*)(ap_ + ks * 128)), __builtin_nontemporal_load((const v4u*)(ap_ + ks * 128 + 16)), 0, 1, 2, 3, 4, 5, 6, 7)); \
        SG[mt] = LISTP[(size_t)((e_) < 64 ? (e_) : 0) * 32768 + (rb_) * 256 + r_]; } } while (0)
    const int NT = NS - NFULL;
    int dk = NFULL, dc = 0, dhi = 1 << 30, de = 0;
    if (NT > 0) { const DnSeg sd_ = seg(NFULL); dc = sd_.c_lo; dhi = sd_.c_hi; de = find_expert(bst, sd_.blk); }
#define DN_ADV_D() do { ++dc; if (dc >= dhi) { ++dk; if (dk < NS) { const DnSeg sd_ = seg(dk); dc = sd_.c_lo; dhi = sd_.c_hi; de = find_expert(bst, sd_.blk); } else { dc = 0; dhi = 1 << 30; } } } while (0)
    v8i32 Af[2][2]; unsigned sgp[2];
    f32x4 accA[2][8], accB[2][8];
    int pe_e = 0, pe_rb = 0, pe_nv = 0, pe_c = 0; unsigned pe_sgp[2] = {0u, 0u}; bool pend = false;
    int g = 0;
    int e = 0, rb = 0, nv = 0;
    if (NFULL > 0) {
        int blk = x * Q + jj;
        e = find_expert(bst, blk); rb = blk - bst[e]; nv = bst[66 + e] - rb * 256; nv = nv > 256 ? 256 : nv;
        int t0e = e, t0c = 0, t1e = e, t1c = 1;
        if (NT > 0) { t0e = de; t0c = dc; DN_ADV_D(); t1e = de; t1c = dc & 7; DN_ADV_D(); }
        DN_STAGE(0, e, 0); DN_STAGE(1, e, 1);
        DN_LOADA(Af, sgp, blk, e, rb);
        for (int ui = 0;; ++ui) {
            const bool next_full = ui + 1 < NFULL, has_next = next_full || NT > 0;
            int blk_n = blk, e_n = e, rb_n = rb, nv_n = nv, n0e = e, n0c = 0, n1e = e, n1c = 1;
            if (next_full) { blk_n = x * Q + (ui + 1) * per + jj; e_n = find_expert(bst, blk_n); n0e = e_n; n1e = e_n; }
            else if (NT > 0) { blk_n = seg(NFULL).blk; e_n = find_expert(bst, blk_n); n0e = t0e; n0c = t0c; n1e = t1e; n1c = t1c; }
            if (has_next) { rb_n = blk_n - bst[e_n]; nv_n = bst[66 + e_n] - rb_n * 256; nv_n = nv_n > 256 ? 256 : nv_n; }
#pragma unroll
            for (int c = 0; c < 8; ++c) {
                if (c == 0) asm volatile("s_waitcnt vmcnt(14)" ::: "memory"); else DN_WAIT4();
                DN_BAR();
                if (c == 0) { if (pend) DN_EPI(accB, 7);
                    pe_e = e; pe_rb = rb; pe_nv = nv; pe_sgp[0] = sgp[0]; pe_sgp[1] = sgp[1]; }
                else if (c & 1) DN_EPI(accA, c - 1); else DN_EPI(accB, c - 1);
                asm volatile("" ::: "memory");
                if (c != 0) { const int s2 = (g + 2) % 3; if (c < 6) DN_STAGE(s2, e, c + 2); else if (c == 6) DN_STAGE(s2, n0e, n0c); else DN_STAGE(s2, n1e, n1c); }
                asm volatile("" ::: "memory");
                { const int s0 = g % 3; if (c & 1) DN_COMPUTE(accB, s0); else DN_COMPUTE(accA, s0); }
                if (c == 0) { asm volatile("" ::: "memory"); DN_STAGE((g + 2) % 3, e, 2); asm volatile("" ::: "memory"); }
                ++g;
            }
            pend = true; pe_c = 7;
            if (!has_next) break;
            blk = blk_n; e = e_n; rb = rb_n; nv = nv_n;
            DN_LOADA(Af, sgp, blk, e, rb);
            if (!next_full) break;
        }
    }
    bool oddlast = true;
    if (NT > 0) {
        int k = NFULL; DnSeg sc = seg(NFULL); int c = sc.c_lo;
        if (NFULL == 0) {
            e = find_expert(bst, sc.blk); rb = sc.blk - bst[e]; nv = bst[66 + e] - rb * 256; nv = nv > 256 ? 256 : nv;
            DN_STAGE(0, de, dc & 7); DN_ADV_D(); DN_STAGE(1, de, dc & 7); DN_ADV_D();
            DN_LOADA(Af, sgp, sc.blk, e, rb);
        }
#define DN_STEP(ACC, PRV) do { const bool first_ = (c == sc.c_lo); \
            if (first_) asm volatile("s_waitcnt vmcnt(14)" ::: "memory"); else DN_WAIT4(); \
            DN_BAR(); \
            if (pend) DN_EPI(PRV, pe_c); \
            if (first_) { pe_e = e; pe_rb = rb; pe_nv = nv; pe_sgp[0] = sgp[0]; pe_sgp[1] = sgp[1]; } \
            asm volatile("" ::: "memory"); \
            if (!first_) { DN_STAGE((g + 2) % 3, de, dc & 7); DN_ADV_D(); } \
            asm volatile("" ::: "memory"); \
            DN_COMPUTE(ACC, g % 3); \
            if (first_) { asm volatile("" ::: "memory"); DN_STAGE((g + 2) % 3, de, dc & 7); DN_ADV_D(); asm volatile("" ::: "memory"); } \
            pe_c = c; pend = true; ++g; ++c; \
            if (c >= sc.c_hi) { ++k; if (k >= NS) { done = true; } else { sc = seg(k); c = sc.c_lo; e = find_expert(bst, sc.blk); rb = sc.blk - bst[e]; nv = bst[66 + e] - rb * 256; nv = nv > 256 ? 256 : nv; \
                DN_LOADA(Af, sgp, sc.blk, e, rb); } } } while (0)
        bool done = false;
        for (;;) {
            DN_STEP(accA, accB); if (done) { oddlast = false; break; }
            DN_STEP(accB, accA); if (done) { oddlast = true; break; }
        }
    }
    asm volatile("s_waitcnt vmcnt(4)" ::: "memory");
    if (oddlast) DN_EPI(accB, pe_c); else DN_EPI(accA, pe_c);
    asm volatile("s_waitcnt vmcnt(0)" ::: "memory");
#undef DN_STAGE
#undef DN_WAIT4
#undef DN_BAR
#undef DN_COMPUTE
#undef DN_LDB
#undef DN_EPI
#undef DN_LOADA
#undef DN_ADV_D
#undef DN_STEP
}

__device__ __forceinline__ void combine_phase(Frame& F) {
    const int gw = F.c * NWAVES + F.wave, NGW = F.G * NWAVES, lane = lane_id();
    const bf16* HB = WSP(const bf16, WS_HB); const unsigned char* CT = WSP(const unsigned char, WS_CONTRIB); const unsigned char* C9 = WSP(const unsigned char, WS_CONTRIB9);
    f32x4 gg[4];
    { const f32x4* gp = (const f32x4*)(karg_in(19) + lane * 16);
#pragma unroll
      for (int q = 0; q < 4; ++q) gg[q] = gp[q]; }
    v4u nh0, nh1, nc[9];
#define P9_LOAD(tt) do { nh0 = __builtin_nontemporal_load((const v4u*)(HB + (size_t)(tt) * D + lane * 16)); nh1 = __builtin_nontemporal_load((const v4u*)(HB + (size_t)(tt) * D + lane * 16 + 8)); \
        _Pragma("unroll") for (int k = 0; k < 9; ++k) nc[k] = __builtin_nontemporal_load((const v4u*)((k < 8 ? CT + ((size_t)(tt) * 8 + k) * 1024 : C9 + (size_t)(tt) * 1024) + lane * 16)); } while (0)
    int t = gw;
    if (t < T) P9_LOAD(t);
    for (; t < T; t += NGW) {
        const v4u h0 = nh0, h1 = nh1; v4u cw[9];
#pragma unroll
        for (int k = 0; k < 9; ++k) cw[k] = nc[k];
        if (t + NGW < T) P9_LOAD(t + NGW);
        float v[16];
        v[0] = bflo(h0.x); v[1] = bfhi(h0.x); v[2] = bflo(h0.y); v[3] = bfhi(h0.y); v[4] = bflo(h0.z); v[5] = bfhi(h0.z); v[6] = bflo(h0.w); v[7] = bfhi(h0.w);
        v[8] = bflo(h1.x); v[9] = bfhi(h1.x); v[10] = bflo(h1.y); v[11] = bfhi(h1.y); v[12] = bflo(h1.z); v[13] = bfhi(h1.z); v[14] = bflo(h1.w); v[15] = bfhi(h1.w);
#pragma unroll
        for (int k = 0; k < 9; ++k) { const unsigned w4[4] = {cw[k].x, cw[k].y, cw[k].z, cw[k].w};
#pragma unroll
            for (int q = 0; q < 4; ++q) { const f32x2 lo = __builtin_amdgcn_cvt_pk_f32_fp8((int)w4[q], false), hi = __builtin_amdgcn_cvt_pk_f32_fp8((int)w4[q], true);
                v[4 * q + 0] += lo.x * CINV; v[4 * q + 1] += lo.y * CINV; v[4 * q + 2] += hi.x * CINV; v[4 * q + 3] += hi.y * CINV; } }
        float ss = 0.f;
#pragma unroll
        for (int j = 0; j < 16; ++j) ss += v[j] * v[j];
        const float rstd = 1.0f / sqrtf(wave_sum(ss) * (1.f / D) + EPS);
        f32x4* op = (f32x4*)(F.out + (size_t)t * D + lane * 16);
#pragma unroll
        for (int q = 0; q < 4; ++q) { const f32x4 g = gg[q]; op[q] = (f32x4){v[4 * q] * rstd * g.x, v[4 * q + 1] * rstd * g.y, v[4 * q + 2] * rstd * g.z, v[4 * q + 3] * rstd * g.w}; }
    }
#undef P9_LOAD
}

constexpr int N_PHASES = 10;
__global__ void __launch_bounds__(NWAVES * 64, 2) fwd(Args args) {
    extern __shared__ __attribute__((aligned(16))) unsigned char lds[];
    Frame F;
    F.lds = (LAS unsigned char*)lds; F.MISC = (volatile LAS unsigned*)(F.lds + MISC_OFF);
    F.wave = __builtin_amdgcn_readfirstlane((int)threadIdx.x >> 6);
    F.G = gridDim.x; F.c = blockIdx.x; F.variant = args.variant; F.ws = args.ws; F.out = args.out; F.ctl = (unsigned*)(args.ws + WS_CTL);
    for (int u = (F.wave * 64 + lane_id()); u < 256; u += NWAVES * 64) ((LAS unsigned*)(F.lds + MISC_OFF))[u] = 0u;
    __syncthreads();
    XcdBarrier bar; bar.bar = F.ctl + CW_BAR + args.li * XCD_BAR_WORDS; bar.x = 0; bar.st = nullptr; bar.wave = 0;
    const int lo = args.ph_lo, hi = args.ph_hi;
    if (hi - lo > 1) bar = xcd_barrier_post(F.ctl + CW_BAR + args.li * XCD_BAR_WORDS, F.MISC + 8, F.wave);
#ifndef PH_MASK
#define PH_MASK 0x3ff
#endif
#define IN(k) (((PH_MASK >> (k)) & 1) && lo <= (k) && (k) < hi)
#define SEAM(k) do { if (IN(k) && IN((k) + 1)) xcd_barrier(bar); } while (0)
    volatile LAS int* bst = (volatile LAS int*)(F.MISC + 64);

    if (IN(0)) { p0_prologue(F); } SEAM(0);
    if (IN(1)) {
        StaticOrder S; S.init(WSP(bf16, WS_XN), WSP(bf16, WS_WIN), T, DIN, D, D, D, F.G, F.c);
        EpiZ E{WSP(bf16, WS_Z), WSP(const float, WS_RSTD1), WSP(bf16, WS_CF)};
        pg8::gemm_phase<EpiZ, StaticOrder, true, false>(F.lds, S, E, F.wave);
    } SEAM(1);
    if (IN(2)) { for (int it = F.c; it < T / 128; it += F.G) sgu_item(F, it);
    } SEAM(2);
    if (IN(3)) { f2_phase(F); } SEAM(3);
    if (IN(4)) { for (int it = F.c; it < T / 64; it += F.G) f3_item(F, it); } SEAM(4);
    if (IN(5)) {
        StaticOrder S; S.init(WSP(bf16, WS_MIX), WSP(bf16, WS_WOUT), T, D, D, D, D, F.G, F.c);
        EpiH E{WSP(const bf16, WS_XN), WSP(bf16, WS_HB), WSP(float, WS_SSP), WSP(unsigned char, WS_HB8)};
        pg8::gemm_phase<EpiH, StaticOrder, true, false>(F.lds, S, E, F.wave);
    } SEAM(5);
#if DBG_STOP >= 6
    if (IN(6)) { route_phase(F); } SEAM(6);
#endif
#if DBG_STOP >= 7
    if (IN(7)) {
        build_bst(F, bst);
        SchedGU S; S.hb = (const char*)WSP(unsigned char, WS_HB8); S.Wgu = (const char*)WSP(unsigned char, WS_WGU); S.tokp = WSP(const unsigned short, WS_TOKP); S.cnt = F.ctl + CW_CNT; S.bst = bst;
        S.K = 512; S.lda = 512; S.ldb = 512; S.G = F.G; S.c = F.c; S.NU = 2 * bst[65]; S.Q = (S.NU + 7) / 8;
        EpiGU E{WSP(const float, WS_RSL), WSP(const float, WS_RSTD2), (unsigned char*)F.out, bst};
        pg8::gemm_phase<EpiGU, SchedGU, true, true, true>(F.lds, S, E, F.wave);
    } SEAM(7);
#endif
#if DBG_STOP >= 8
    if (IN(8)) {
        build_bst(F, bst);
        down_phase(F, bst);
    } SEAM(8);
#endif
    if (IN(9)) { combine_phase(F); }
#undef IN
#undef SEAM
}

extern "C" void kernel_launch(void* const* d_in, const int* in_sizes, int n_in, void* d_out, int out_size, void* d_ws, size_t ws_size, hipStream_t stream) {
    static int grid = 0;
    if (grid == 0) {
        if (n_in != 20 || in_sizes[0] != T * D || out_size != T * D || ws_size < WS_END) { fprintf(stderr, "kernel_launch: unexpected shapes / workspace (n_in %d, in0 %d, out %d, ws %zu)\n", n_in, n_in > 0 ? in_sizes[0] : -1, out_size, ws_size); grid = -1; return; }
        int dev = 0, cus = 0, per_cu = 0;
        if (hipGetDevice(&dev) != hipSuccess || hipDeviceGetAttribute(&cus, hipDeviceAttributeMultiprocessorCount, dev) != hipSuccess) { grid = -1; return; }
        if (hipFuncSetAttribute((const void*)fwd, hipFuncAttributeMaxDynamicSharedMemorySize, LDS_BYTES) != hipSuccess) { fprintf(stderr, "kernel_launch: hipFuncSetAttribute failed\n"); grid = -1; return; }
        if (hipOccupancyMaxActiveBlocksPerMultiprocessor(&per_cu, (const void*)fwd, NWAVES * 64, LDS_BYTES) != hipSuccess || per_cu < 1) fprintf(stderr, "kernel_launch: occupancy query reports %d\n", per_cu);
        (void)hipGetLastError();
        grid = cus;
        if (grid % 8 != 0 || grid > 1024) { fprintf(stderr, "kernel_launch: unexpected CU count %d\n", cus); }
    }
    if (grid < 0) return;
    if (hipMemsetAsync((char*)d_ws + WS_CTL, 0, CTL_ZERO_BYTES, stream) != hipSuccess) return;
    Args a{};
    for (int i = 0; i < 20; ++i) a.in[i] = (const float*)d_in[i];
    a.out = (float*)d_out; a.ws = (unsigned char*)d_ws;
    const int nl = MK_N_LAUNCHES;
    for (int li = 0; li < nl; ++li) {
        a.ph_lo = (nl == N_PHASES) ? li : (li * N_PHASES) / nl; a.ph_hi = (nl == N_PHASES) ? li + 1 : ((li + 1) * N_PHASES) / nl; a.li = li;
#if defined(REP_MASK)
        if (nl == N_PHASES && ((REP_MASK >> li) & 1)) for (int rep = 0; rep < REP_N; ++rep) { a.variant = REP_VARIANT; hipLaunchKernelGGL(fwd, dim3(grid), dim3(NWAVES * 64), LDS_BYTES, stream, a); a.variant = 0;
            if (li == 6) (void)hipMemsetAsync((char*)d_ws + WS_CTL + CW_CNT * 4, 0, 256, stream); }
#endif
        hipLaunchKernelGGL(fwd, dim3(grid), dim3(NWAVES * 64), LDS_BYTES, stream, a);
        if (hipPeekAtLastError() != hipSuccess) { fprintf(stderr, "kernel_launch: launch %d failed\n", li); break; }

    }
}
```

```cpp
#include <hip/hip_runtime.h>
#include <cstdio>
#include <cstdint>

#ifndef MK_N_LAUNCHES
#define MK_N_LAUNCHES 1
#endif
#ifndef DBG_STOP
#define DBG_STOP 99
#endif

#define GAS __attribute__((address_space(1)))
#define LAS __attribute__((address_space(3)))
typedef unsigned short bf16;
typedef unsigned v4u __attribute__((ext_vector_type(4)));
typedef unsigned v2u __attribute__((ext_vector_type(2)));
typedef float f32x4 __attribute__((ext_vector_type(4)));
typedef float f32x2 __attribute__((ext_vector_type(2)));
typedef short bf16x8 __attribute__((ext_vector_type(8)));

constexpr int T = 32768, D = 1024, DIN = 1536, DA = 512, NE = 64, DE = 256, SEQ = 4096, NB_ = 8;
constexpr float EPS = 1e-6f;
constexpr int NCOLF = 8 * 8 * 33;
constexpr float CSCALE = 16.0f, CINV = 1.0f / 16.0f;

constexpr size_t MiB = 1u << 20;
constexpr size_t WS_CTL = 0, CTL_ZERO_BYTES = 65536;
constexpr size_t WS_WIN = 1 * MiB;
constexpr size_t WS_WOUT = 4 * MiB;
constexpr size_t WS_WR = 6 * MiB;
constexpr size_t WS_WSB = 6 * MiB + 256 * 1024;
constexpr size_t WS_TW = 6 * MiB + 512 * 1024;
constexpr size_t WS_RSTD2 = 6 * MiB + 768 * 1024;
constexpr int FB_OFF = 0, GT_OFF = 34816, TWL_OFF = 52224, XI_OFF = 68608, XI_SZ = 18432, TI_OFF = 105472, FPITCH = 272, XPITCH = 144;
constexpr size_t WS_F2IMG = 7 * MiB;
constexpr size_t WS_RSTD1 = 6 * MiB + 896 * 1024;
constexpr size_t WS_SSP = 8 * MiB;
constexpr size_t WS_LIST = 10 * MiB;
constexpr size_t WS_RSL = 18 * MiB;
constexpr size_t WS_GL = 26 * MiB;
constexpr size_t WS_TOKP = 34 * MiB;
constexpr size_t WS_WGU = 38 * MiB;
constexpr size_t WS_WD = 71 * MiB;
constexpr size_t WS_HB = 88 * MiB;
constexpr size_t WS_HB8 = 152 * MiB;
constexpr size_t WS_CONTRIB = 184 * MiB;
constexpr size_t WS_XN = 184 * MiB;
constexpr size_t WS_MIX = 411 * MiB;
constexpr size_t WS_Z = 248 * MiB;
constexpr size_t WS_CF = 344 * MiB;
constexpr size_t WS_YT = 378 * MiB;
constexpr size_t WS_CONTRIB9 = 440 * MiB;
constexpr size_t WS_TRASH = 6 * MiB + 512 * 1024 + 65536;
constexpr size_t WS_END = 512 * MiB;
constexpr float WSCALE = 64.0f, HSCALE = 8.0f;
__device__ __forceinline__ float sat8(float x) { return __builtin_amdgcn_fmed3f(x, -440.0f, 440.0f); }
constexpr int CW_BAR = 4096;
constexpr int CW_CNT = 8192;

constexpr int RING_BYTES = 131072;
constexpr int LDS_BYTES = 155648;
constexpr int MISC_OFF = LDS_BYTES - 1024;
constexpr int NWAVES = 8;

#define LDS_WAIT() asm volatile("s_waitcnt lgkmcnt(0)" ::: "memory")
#define VM_WAIT() asm volatile("s_waitcnt vmcnt(0)" ::: "memory")
#define LDS_BARRIER() do { asm volatile("s_waitcnt lgkmcnt(0)" ::: "memory"); __builtin_amdgcn_s_barrier(); asm volatile("" ::: "memory"); } while (0)
__device__ __forceinline__ unsigned f2bf(float f) { unsigned u = __builtin_bit_cast(unsigned, f); return (u + 0x7fffu + ((u >> 16) & 1u)) >> 16; }
__device__ __forceinline__ unsigned pk2(float lo, float hi) { return f2bf(lo) | (f2bf(hi) << 16); }
__device__ __forceinline__ float bflo(unsigned w) { return __builtin_bit_cast(float, w << 16); }
__device__ __forceinline__ float bfhi(unsigned w) { return __builtin_bit_cast(float, w & 0xffff0000u); }
__device__ __forceinline__ int lane_id() { int r; asm volatile("v_mbcnt_lo_u32_b32 %0, -1, 0\n\tv_mbcnt_hi_u32_b32 %0, -1, %0" : "=v"(r)); return r; }
template <int CTRL> __device__ __forceinline__ float dpp_f(float v) { return __builtin_bit_cast(float, __builtin_amdgcn_update_dpp(0, __builtin_bit_cast(int, v), CTRL, 0xF, 0xF, false)); }
template <int CTRL> __device__ __forceinline__ int dpp_i(int v) { return __builtin_amdgcn_update_dpp(0, v, CTRL, 0xF, 0xF, false); }
__device__ __forceinline__ float xor16_sum(float v) { const auto s = __builtin_amdgcn_permlane16_swap(__builtin_bit_cast(unsigned, v), __builtin_bit_cast(unsigned, v), false, false); return __builtin_bit_cast(float, (unsigned)s[0]) + __builtin_bit_cast(float, (unsigned)s[1]); }
__device__ __forceinline__ float xor32_sum(float v) { const auto s = __builtin_amdgcn_permlane32_swap(__builtin_bit_cast(unsigned, v), __builtin_bit_cast(unsigned, v), false, false); return __builtin_bit_cast(float, (unsigned)s[0]) + __builtin_bit_cast(float, (unsigned)s[1]); }
__device__ __forceinline__ float row16_sum(float v) { v += dpp_f<0xB1>(v); v += dpp_f<0x4E>(v); v += dpp_f<0x141>(v); v += dpp_f<0x140>(v); return v; }
__device__ __forceinline__ float wave_sum(float v) { return xor32_sum(xor16_sum(row16_sum(v))); }

namespace pg8 {
constexpr int BM = 256, BK = 64, HALF = 128, HTB = HALF * BK * 2, STAGE_BYTES = 8 * HTB;
__host__ __device__ __forceinline__ int lds_byte(int r, int c) { const int st = (r >> 4) * 2 + (c >> 5), rr = r & 15, cc = c & 31, ob = rr * 64 + cc * 2; return st * 1024 + (ob ^ (((ob >> 9) & 1) << 5)); }
__host__ __device__ __forceinline__ void stage_rc(int b, int& R, int& C) { const int st = b / 1024, sb = b % 1024, swz = sb ^ (((sb >> 9) & 1) << 5); R = (st >> 1) * 16 + swz / 64; C = (st & 1) * 32 + (swz % 64) / 2; }
__host__ __device__ __forceinline__ int perm32(int rho) { const int n = rho >> 4, i = rho & 15; return 8 * (i >> 2) + 4 * n + (i & 3); }
__host__ __device__ __forceinline__ int perm32b(int rho) { const int n = rho >> 4, i = rho & 15, q = i >> 2; return 16 * (q & 1) + 8 * (q >> 1) + 4 * n + (i & 3); }

struct Unit { const char* A; const char* B; int pm, pn, e, nvalid; };

__device__ __forceinline__ unsigned cvt_pk_bf16(float lo, float hi) { unsigned r; asm volatile("v_cvt_pk_bf16_f32 %0, %1, %2" : "=v"(r) : "v"(lo), "v"(hi)); return r; }
__device__ __forceinline__ f32x2 gelu_pk(f32x2 v) {
    const f32x2 av = __builtin_elementwise_abs(v), d = av * 0.2316418882f + 1.0f;
    f32x2 t; t.x = __builtin_amdgcn_rcpf(d.x); t.y = __builtin_amdgcn_rcpf(d.y);
    f32x2 q = t * 0.5307027145f + (-0.7265760135f); q = q * t + 0.7107068705f; q = q * t + (-0.142248368f); q = q * t + 0.127414796f; q = q * t;
    const f32x2 s = (v * v) * (-0.72134752044f);
    f32x2 e; e.x = __builtin_amdgcn_exp2f(s.x); e.y = __builtin_amdgcn_exp2f(s.y);
    const f32x2 m = v * (q * e), r = v - m;
    f32x2 o; o.x = v.x < 0.f ? m.x : r.x; o.y = v.y < 0.f ? m.y : r.y; return o;
}

typedef int v8i32 __attribute__((ext_vector_type(8)));
typedef unsigned v8u32 __attribute__((ext_vector_type(8)));
template <class Epi, class Sched, bool ALIGN_EPI, bool GATHER, bool FP8 = false>
__device__ __forceinline__ void gemm_phase(LAS unsigned char* lds, const Sched& S, const Epi& E, int wid) {
    const int lane = lane_id(), tid = wid * 64 + lane, wr = wid >> 2, wc = wid & 3, fr = lane & 15, fq = lane >> 4;
    const int K = S.K, nt = K / BK, lda = S.lda, ldb = S.ldb;
    unsigned voffA[2], voffB[2]; int RA[2];
#pragma unroll
    for (int i = 0; i < 2; ++i) { int R, C; stage_rc(tid * 16 + i * 8192, R, C); const int Rb = Epi::PERM == 2 ? ((R & ~31) + perm32b(R & 31)) : (Epi::PERM ? ((R & ~31) + perm32(R & 31)) : R);
        const int Ra = Epi::PERM_A ? ((R & ~31) + perm32(R & 31)) : R;
        voffA[i] = GATHER ? (unsigned)(C * 2) : (unsigned)(Ra * lda + C) * 2u; voffB[i] = (unsigned)(Rb * ldb + C) * 2u; RA[i] = R; }
    const size_t kstep = (size_t)(BK * 2);
    const size_t hstepA = (size_t)HALF * lda * 2, hstepB = (size_t)HALF * ldb * 2;
    const unsigned ldsw = (unsigned)wid * 1024u;
    const int aoff = lds_byte(wr * 64 + fr, fq * 8), boff = lds_byte(wc * 32 + fr, fq * 8);
#define PG8_SA(b, h) (((b) * 2 + (h)) * HTB)
#define PG8_SB(b, h) ((4 + (b) * 2 + (h)) * HTB)
#define PG8_GLDS(gp, bufoff, i_) __builtin_amdgcn_global_load_lds((const unsigned*)(gp), (LAS unsigned*)(lds + (bufoff) + ldsw + (i_) * 8192), 16, 0, 0)
#define PG8_STAGE_B(bufoff, gbase) do { PG8_GLDS((const char*)(gbase) + voffB[0], bufoff, 0); PG8_GLDS((const char*)(gbase) + voffB[1], bufoff, 1); } while (0)
#define PG8_STAGE_A(bufoff, gbase, h_, o_) do { if constexpr (GATHER) { PG8_GLDS((const char*)(gbase) + ((o_[h_] & 0x7fffu) * (unsigned)(lda * 2) + voffA[0]), bufoff, 0); PG8_GLDS((const char*)(gbase) + (((o_[h_] >> 16) & 0x7fffu) * (unsigned)(lda * 2) + voffA[1]), bufoff, 1); } \
        else { PG8_GLDS((const char*)(gbase) + (h_) * hstepA + voffA[0], bufoff, 0); PG8_GLDS((const char*)(gbase) + (h_) * hstepA + voffA[1], bufoff, 1); } } while (0)
#define PG8_LD8(p_) __builtin_shufflevector(*(const LAS v4u*)(p_), *(const LAS v4u*)((p_) + 1024), 0, 1, 2, 3, 4, 5, 6, 7)
#define PG8_LDA(dst, b, h) do { _Pragma("unroll") for (int m = 0; m < 4; ++m) dst[m] = PG8_LD8(lds + PG8_SA(b, h) + aoff + m * 2048); } while (0)
#define PG8_LDB(dst, b, h) do { _Pragma("unroll") for (int n = 0; n < 2; ++n) dst[n] = PG8_LD8(lds + PG8_SB(b, h) + boff + n * 2048); } while (0)
#define PG8_MMA(ai, bj, At, Bt) do { __builtin_amdgcn_s_setprio(1); _Pragma("unroll") for (int m = 0; m < 4; ++m) _Pragma("unroll") for (int n = 0; n < 2; ++n) { \
        if constexpr (FP8) { acc[ai][bj][m][n] = __builtin_amdgcn_mfma_scale_f32_16x16x128_f8f6f4(__builtin_bit_cast(v8i32, Bt[n]), __builtin_bit_cast(v8i32, At[m]), acc[ai][bj][m][n], 0, 0, 0, Epi::SCALE_B, 0, Epi::SCALE_A); } \
        else { acc[ai][bj][m][n] = __builtin_amdgcn_mfma_f32_16x16x32_bf16(__builtin_bit_cast(bf16x8, __builtin_shufflevector(Bt[n], Bt[n], 0, 1, 2, 3)), __builtin_bit_cast(bf16x8, __builtin_shufflevector(At[m], At[m], 0, 1, 2, 3)), acc[ai][bj][m][n], 0, 0, 0); \
               acc[ai][bj][m][n] = __builtin_amdgcn_mfma_f32_16x16x32_bf16(__builtin_bit_cast(bf16x8, __builtin_shufflevector(Bt[n], Bt[n], 4, 5, 6, 7)), __builtin_bit_cast(bf16x8, __builtin_shufflevector(At[m], At[m], 4, 5, 6, 7)), acc[ai][bj][m][n], 0, 0, 0); } } \
        if constexpr (FP8) { _Pragma("unroll") for (int m = 0; m < 4; ++m) _Pragma("unroll") for (int n = 0; n < 2; ++n) asm volatile("" : "+v"(acc[ai][bj][m][n])); }     \
        __builtin_amdgcn_s_setprio(0); } while (0)
#define PG8_MMAT(ai, bj, At, Bt) do { __builtin_amdgcn_s_setprio(1); _Pragma("unroll") for (int m = 0; m < 4; ++m) _Pragma("unroll") for (int n = 0; n < 2; ++n) { \
        acc[ai][bj][m][n] = __builtin_amdgcn_mfma_f32_16x16x32_bf16(__builtin_bit_cast(bf16x8, __builtin_shufflevector(At[m], At[m], 0, 1, 2, 3)), __builtin_bit_cast(bf16x8, __builtin_shufflevector(Bt[n], Bt[n], 0, 1, 2, 3)), acc[ai][bj][m][n], 0, 0, 0); \
        acc[ai][bj][m][n] = __builtin_amdgcn_mfma_f32_16x16x32_bf16(__builtin_bit_cast(bf16x8, __builtin_shufflevector(At[m], At[m], 4, 5, 6, 7)), __builtin_bit_cast(bf16x8, __builtin_shufflevector(Bt[n], Bt[n], 4, 5, 6, 7)), acc[ai][bj][m][n], 0, 0, 0); } \
        __builtin_amdgcn_s_setprio(0); } while (0)
#define PG8_WAIT_V(n) asm volatile("s_waitcnt vmcnt(" #n ")" ::: "memory")
#define PG8_WAIT_L(n) asm volatile("s_waitcnt lgkmcnt(" #n ")" ::: "memory")
#define PG8_BAR __builtin_amdgcn_s_barrier()
#define PG8_SCHED __builtin_amdgcn_sched_barrier(0)
#define PG8_KLOOP(MMAX) \
        for (int t = 0; t < nt; t += 2) { \
            const bool last = (t == nt - 2); \
            const char* a1 = cA + (size_t)(t + 1) * kstep; \
            const char* a2 = last ? nA : cA + (size_t)(t + 2) * kstep; const char* b2 = last ? nB : cB + (size_t)(t + 2) * kstep; \
            const char* a3 = a2 + kstep; const char* b3 = b2 + kstep; \
            unsigned o2[2]; \
_Pragma("unroll") \
            for (int h = 0; h < 2; ++h) o2[h] = last ? on[h] : oc[h]; \
            PG8_LDB(B0, 0, 0); PG8_LDB(B1, 0, 1); PG8_SCHED; PG8_LDA(At, 0, 0); PG8_STAGE_A(PG8_SA(1, 1), a1, 1, oc); \
            PG8_WAIT_V(8); PG8_WAIT_L(0); PG8_BAR; MMAX(0, 0, At, B0); MMAX(0, 1, At, B1); PG8_BAR; PG8_SCHED; \
            PG8_LDA(At, 0, 1); PG8_STAGE_B(PG8_SB(0, 0), b2); PG8_STAGE_B(PG8_SB(0, 1), b2 + hstepB); PG8_STAGE_A(PG8_SA(0, 0), a2, 0, o2); \
            PG8_WAIT_V(8); PG8_WAIT_L(0); PG8_BAR; MMAX(1, 0, At, B0); MMAX(1, 1, At, B1); PG8_BAR; PG8_SCHED; \
            PG8_LDB(B0, 1, 0); PG8_LDB(B1, 1, 1); PG8_SCHED; PG8_LDA(At, 1, 0); PG8_STAGE_A(PG8_SA(0, 1), a2, 1, o2); \
            PG8_WAIT_V(8); PG8_WAIT_L(0); PG8_BAR; MMAX(0, 0, At, B0); MMAX(0, 1, At, B1); PG8_BAR; PG8_SCHED; \
            PG8_LDA(At, 1, 1); PG8_STAGE_B(PG8_SB(1, 0), b3); PG8_STAGE_B(PG8_SB(1, 1), b3 + hstepB); PG8_STAGE_A(PG8_SA(1, 0), a3, 0, o2); \
            PG8_WAIT_V(8); PG8_WAIT_L(0); PG8_BAR; MMAX(1, 0, At, B0); MMAX(1, 1, At, B1); PG8_BAR; PG8_SCHED; \
        }
    Unit cur, nxt; int ui = 0;
    if (!S.next(0, cur)) return;
    f32x4 acc[2][2][4][2];
#pragma unroll
    for (int a = 0; a < 2; ++a)
#pragma unroll
        for (int b = 0; b < 2; ++b)
#pragma unroll
            for (int m = 0; m < 4; ++m)
#pragma unroll
                for (int n = 0; n < 2; ++n) acc[a][b][m][n] = (f32x4){0.f, 0.f, 0.f, 0.f};
    v8u32 At[4], B0[2], B1[2];
    unsigned oc[2], on[2];
#pragma unroll
    for (int h = 0; h < 2; ++h) { oc[h] = GATHER ? S.gather2(cur, h, RA[0]) : 0u; on[h] = oc[h]; }
    const char* cA = cur.A; const char* cB = cur.B;
    PG8_STAGE_B(PG8_SB(0, 0), cB); PG8_STAGE_B(PG8_SB(0, 1), cB + hstepB); PG8_STAGE_A(PG8_SA(0, 0), cA, 0, oc); PG8_STAGE_A(PG8_SA(0, 1), cA, 1, oc);
    if (wr == 1) PG8_BAR;
    PG8_WAIT_V(2); PG8_BAR;
    PG8_STAGE_B(PG8_SB(1, 0), cB + kstep); PG8_STAGE_A(PG8_SA(1, 0), cA + kstep, 0, oc); PG8_STAGE_B(PG8_SB(1, 1), cB + hstepB + kstep);
    PG8_WAIT_V(6); PG8_BAR;
    for (;;) {
        const bool has_next = S.next(ui + 1, nxt);
        const char* nA = has_next ? nxt.A : cA; const char* nB = has_next ? nxt.B : cB;
        if constexpr (GATHER) {
            if (has_next) {
#pragma unroll
                for (int h = 0; h < 2; ++h) on[h] = S.gather2(nxt, h, RA[0]);
            }
        }
        unsigned pf[2];
        if constexpr (Epi::PREFETCH) E.prefetch(cur, wr, fr, fq, pf);
        if constexpr (Epi::DUAL) { if (E.transposed(cur)) { PG8_KLOOP(PG8_MMAT) } else { PG8_KLOOP(PG8_MMA) } } else { PG8_KLOOP(PG8_MMA) }
        if constexpr (ALIGN_EPI) { if (wr == 0) PG8_BAR; }
        if constexpr (Epi::DUAL) { if (E.transposed(cur)) E.epiT(acc, cur, wr, wc, fr, fq); else E(acc, cur, wr, wc, fr, fq); }
        else if constexpr (Epi::PREFETCH) E(acc, cur, wr, wc, fr, fq, pf); else E(acc, cur, wr, wc, fr, fq);
        if (!has_next) break;
#pragma unroll
        for (int a = 0; a < 2; ++a)
#pragma unroll
            for (int b = 0; b < 2; ++b)
#pragma unroll
                for (int m = 0; m < 4; ++m)
#pragma unroll
                    for (int n = 0; n < 2; ++n) acc[a][b][m][n] = (f32x4){0.f, 0.f, 0.f, 0.f};
        cur = nxt; cA = nA; cB = nB; ++ui;
        oc[0] = on[0]; oc[1] = on[1];
        if constexpr (ALIGN_EPI) { if (wr == 1) PG8_BAR; }
    }
    PG8_WAIT_V(0);
    if constexpr (!ALIGN_EPI) { if (wr == 0) PG8_BAR; }
    PG8_BAR;
#undef PG8_SA
#undef PG8_SB
#undef PG8_GLDS
#undef PG8_STAGE_A
#undef PG8_STAGE_B
#undef PG8_LDA
#undef PG8_LDB
#undef PG8_MMA
#undef PG8_MMAT
#undef PG8_KLOOP
#undef PG8_WAIT_V
#undef PG8_WAIT_L
#undef PG8_BAR
#undef PG8_SCHED
}
}

#define XB_TMO      128
#define XB_XCNT(j)  (256  + 64 * (j))
#define XB_XSUB(j)  (1280 + 64 * (j))
#define XB_XGEN(j)  (2304 + 64 * (j))
#define XB_TOP      3328
#define XB_TOPGEN   3392
#define XCD_BAR_WORDS 3456
#define XB_SPIN_CAP (1u << 18)
__device__ __forceinline__ unsigned xb_ld(unsigned* p)              { return __hip_atomic_load(p, __ATOMIC_RELAXED, __HIP_MEMORY_SCOPE_AGENT); }
__device__ __forceinline__ unsigned xb_add(unsigned* p, unsigned v) { return __hip_atomic_fetch_add(p, v, __ATOMIC_RELAXED, __HIP_MEMORY_SCOPE_AGENT); }
__device__ __forceinline__ unsigned xb_xcc_id() { return (unsigned)__builtin_amdgcn_s_getreg((3 << 11) | 20) & 0xFu; }
#define XB_SPIN(cond, bar) do { unsigned _sp = 0; while (cond) { __builtin_amdgcn_s_sleep(1); \
    if ((++_sp & 255u) == 0u) { if (xb_ld(&(bar)[XB_TMO])) break; if (_sp > XB_SPIN_CAP) { atomicAdd(&(bar)[XB_TMO], 1u); break; } } } } while (0)
struct XcdBarrier { unsigned* bar; unsigned x; volatile LAS unsigned* st; int wave; };
__device__ __forceinline__ XcdBarrier xcd_barrier_post(unsigned* bar, volatile LAS unsigned* st, int wave) {
    XcdBarrier b; b.bar = bar; b.x = xb_xcc_id(); b.st = st; b.wave = wave;
    if (wave == 0 && lane_id() == 0) (void)xb_add(&bar[XB_XCNT(b.x)], 1u);
    return b;
}
__device__ __forceinline__ void xcd_barrier_complete(unsigned* bar, unsigned x, unsigned& nloc, unsigned& nx) {
    const unsigned G = gridDim.x * gridDim.y * gridDim.z;
    unsigned sum, cnt, mine, sp = 0u;
    for (;;) {
        sum = 0u; cnt = 0u; mine = 0u;
#pragma unroll
        for (unsigned j = 0; j < 16; ++j) { const unsigned c = xb_ld(&bar[XB_XCNT(j)]); sum += c; cnt += (c > 0u) ? 1u : 0u; mine = (j == x) ? c : mine; }
        if (sum == G) break;
        __builtin_amdgcn_s_sleep(1);
        if ((++sp & 255u) == 0u) { if (xb_ld(&bar[XB_TMO])) break; if (sp > XB_SPIN_CAP) { atomicAdd(&bar[XB_TMO], 1u); break; } }
    }
    nloc = mine > 0u ? mine : 1u; nx = cnt > 0u ? cnt : 1u;
}
__device__ __forceinline__ void xcd_barrier(const XcdBarrier& b) {
    asm volatile("s_waitcnt vmcnt(0)" ::: "memory");
    __syncthreads();
    if (b.wave == 0 && lane_id() == 0) {
        unsigned* bar = b.bar;
        __builtin_amdgcn_s_waitcnt(0);
        unsigned nloc = b.st[0], nx = b.st[1];
        if (nloc == 0u) { xcd_barrier_complete(bar, b.x, nloc, nx); b.st[0] = nloc; b.st[1] = nx; }
        const unsigned old = xb_add(&bar[XB_XSUB(b.x)], 1u);
        const unsigned gen = old / nloc;
        if (old + 1u == (gen + 1u) * nloc) {
            __builtin_amdgcn_fence(__ATOMIC_RELEASE, "agent");
            asm volatile("s_waitcnt vmcnt(0)" ::: "memory");
            const unsigned og = xb_add(&bar[XB_TOP], 1u);
            const unsigned tg = og / nx;
            if (og + 1u == (tg + 1u) * nx) xb_add(&bar[XB_TOPGEN], 1u);
            else XB_SPIN(xb_ld(&bar[XB_TOPGEN]) == tg, bar);
            __builtin_amdgcn_fence(__ATOMIC_ACQUIRE, "agent");
            xb_add(&bar[XB_XGEN(b.x)], 1u);
            asm volatile("s_waitcnt vmcnt(0)" ::: "memory");
        } else {
            XB_SPIN(xb_ld(&bar[XB_XGEN(b.x)]) == gen, bar);
            __builtin_amdgcn_fence(__ATOMIC_ACQUIRE, "agent");
            asm volatile("s_waitcnt vmcnt(0)" ::: "memory");
        }
    }
    __syncthreads();
}

struct Args { const float* in[20]; float* out; unsigned char* ws; int ph_lo, ph_hi, li, variant; };
struct Frame {
    LAS unsigned char* lds; volatile LAS unsigned* MISC; unsigned* ctl;
    int wave, G, c, variant;
    unsigned char* ws; float* out;
};
#define WSP(T_, off) ((T_*)(F.ws + (off)))
__device__ __forceinline__ const float* karg_in(int i) { return ((const float* const __attribute__((address_space(4)))*)__builtin_amdgcn_kernarg_segment_ptr())[i]; }

struct StaticOrder {
    const char* A; const char* B; int K, lda, ldb; int nM, nN, nwg, G, c;
    __device__ void init(const void* A_, const void* B_, int M, int N, int K_, int lda_, int ldb_, int G_, int c_) { A = (const char*)A_; B = (const char*)B_; K = K_; lda = lda_; ldb = ldb_; nM = M / 256; nN = N / 256; nwg = nM * nN; G = G_; c = c_; }
    __device__ __forceinline__ bool next(int i, pg8::Unit& u) const {
        const long L = (long)i * G + c; if (L >= nwg) return false;
        int wgid = (int)L; { const int q = nwg / 8, r = nwg % 8, xcd = wgid % 8, off = wgid / 8; wgid = (xcd < r ? xcd * (q + 1) : r * (q + 1) + (xcd - r) * q) + off; }
        const int nig = 8 * nN, gid = wgid / nig, fm = gid * 8, gsz = (nM - fm) < 8 ? (nM - fm) : 8;
        u.pm = fm + ((wgid % nig) % gsz); u.pn = (wgid % nig) / gsz; u.e = 0; u.nvalid = 256;
        u.A = A + (size_t)u.pm * 256 * lda * 2; u.B = B + (size_t)u.pn * 256 * ldb * 2; return true;
    }
    __device__ __forceinline__ unsigned gather2(const pg8::Unit&, int, int) const { return 0u; }
};
__device__ __forceinline__ int find_expert(const volatile LAS int* bst, int blk) { int lo = 0, hi = 65; while (hi - lo > 1) { const int mid = (lo + hi) >> 1; if (bst[mid] <= blk) lo = mid; else hi = mid; } return lo; }
struct SchedGU {
    const char* hb; const char* Wgu; const unsigned short* tokp; const unsigned* cnt; const volatile LAS int* bst;
    int K, lda, ldb, G, c, NU, Q;
    __device__ __forceinline__ bool next(int i, pg8::Unit& u) const {
        const int x = c & 7, j = c >> 3, per = G >> 3; const int L = x * Q + i * per + j; int hiL = (x + 1) * Q; hiL = hiL < NU ? hiL : NU;
        if (i * per + j >= Q || L >= hiL) return false;
        int lo = 0, hi = 65; while (hi - lo > 1) { const int mid = (lo + hi) >> 1; if (2 * bst[mid] <= L) lo = mid; else hi = mid; }
        const int e = lo, loc = L - 2 * bst[e], uu = loc & 1, rb = loc >> 1;
        u.e = e; u.pm = rb; u.pn = uu; u.A = hb; u.B = Wgu + ((size_t)e * 512 + uu * 256) * 1024;
        int nv = bst[66 + e] - rb * 256; nv = nv > 256 ? 256 : nv; u.nvalid = nv; return true;
    }
    __device__ __forceinline__ unsigned gather2(const pg8::Unit& u, int h, int R0) const {
        if (u.e >= 64) { const unsigned t = (unsigned)(u.pm * 256 + h * 128 + R0); return t | ((t + 64u) << 16); }
        return *(const unsigned*)(tokp + (size_t)u.e * 32768 + u.pm * 256 + h * 128 + 2 * R0);
    }
};
struct SchedDN {
    const char* hact_lo; const char* hact_hi; const char* Wd; const unsigned* cnt; const volatile LAS int* bst;
    int K, lda, ldb, G, c, NU, Q;
    __device__ __forceinline__ bool next(int i, pg8::Unit& u) const {
        const int x = c & 7, j = c >> 3, per = G >> 3; const int L = x * Q + i * per + j; int hiL = (x + 1) * Q; hiL = hiL < NU ? hiL : NU;
        if (i * per + j >= Q || L >= hiL) return false;
        const int blk = L >> 2, pn = L & 3; const int e = find_expert(bst, blk), rb = blk - bst[e];
        u.e = e; u.pm = rb; u.pn = pn;
        u.A = hact_lo + (size_t)blk * 65536;
        u.B = Wd + ((size_t)e * 1024 + pn * 256) * 256;
        int nv = bst[66 + e] - rb * 256; nv = nv > 256 ? 256 : nv; u.nvalid = nv; return true;
    }
    __device__ __forceinline__ unsigned gather2(const pg8::Unit&, int, int) const { return 0u; }
};

struct EpiZ {
    static constexpr bool PERM_A = true, DUAL = true;
    static constexpr int PERM = 1; static constexpr bool PREFETCH = false; static constexpr int SCALE_A = 0, SCALE_B = 0;
    bf16* Z; const float* rstd1; bf16* CF;
    __device__ __forceinline__ bool transposed(const pg8::Unit& u) const { return u.pn >= 4; }
    __device__ __forceinline__ void operator()(const f32x4 (&acc)[2][2][4][2], const pg8::Unit& u, int wr, int wc, int fr, int fq) const {
        const int row0 = u.pm * 256 + wr * 64 + 8 * (fr >> 2) + (fr & 3), col0 = u.pn * 256 + wc * 32 + 8 * fq;
        float rsv[8];
#pragma unroll
        for (int q = 0; q < 8; ++q) rsv[q] = rstd1[row0 + (q >> 2) * 128 + ((q >> 1) & 1) * 32 + (q & 1) * 4];
#pragma unroll
        for (int ai = 0; ai < 2; ++ai)
#pragma unroll
            for (int m = 0; m < 4; ++m) { bf16* rowp = Z + (size_t)(row0 + ai * 128 + (m >> 1) * 32 + (m & 1) * 4) * DIN + col0; const float rs = rsv[ai * 4 + m];
#pragma unroll
                for (int bj = 0; bj < 2; ++bj) { f32x4 v0 = acc[ai][bj][m][0] * rs, v1 = acc[ai][bj][m][1] * rs;
                    { f32x2 a = pg8::gelu_pk((f32x2){v0[0], v0[1]}), b = pg8::gelu_pk((f32x2){v0[2], v0[3]}), c = pg8::gelu_pk((f32x2){v1[0], v1[1]}), d = pg8::gelu_pk((f32x2){v1[2], v1[3]});
                        v0 = (f32x4){a.x, a.y, b.x, b.y}; v1 = (f32x4){c.x, c.y, d.x, d.y}; }
                    v4u w; w.x = pg8::cvt_pk_bf16(v0[0], v0[1]); w.y = pg8::cvt_pk_bf16(v0[2], v0[3]); w.z = pg8::cvt_pk_bf16(v1[0], v1[1]); w.w = pg8::cvt_pk_bf16(v1[2], v1[3]);
                    *(v4u*)(rowp + bj * 128) = w; } }
    }
    __device__ __forceinline__ void epiT(const f32x4 (&acc)[2][2][4][2], const pg8::Unit& u, int wr, int wc, int fr, int fq) const {
        const int t0 = u.pm * 256, b = t0 >> 12, s0 = (t0 & 4095) + wr * 64 + 8 * fq;
#pragma unroll
        for (int ai = 0; ai < 2; ++ai)
#pragma unroll
            for (int mp = 0; mp < 2; ++mp) { const int s = s0 + ai * 128 + mp * 32;
                const f32x4 r0 = *(const f32x4*)(rstd1 + b * 4096 + s), r1 = *(const f32x4*)(rstd1 + b * 4096 + s + 4);
#pragma unroll
                for (int bj = 0; bj < 2; ++bj)
#pragma unroll
                    for (int n = 0; n < 2; ++n) { const int cg = (u.pn - 4) * 256 + bj * 128 + wc * 32 + 8 * (fr >> 2) + 4 * n + (fr & 3), g = cg >> 6, j = cg & 63;
                        const int plane = ((b * 8 + g) * 33 + (j <= 32 ? j : j - 32)) * 2 + (j <= 32 ? 0 : 1);
                        const f32x4 v0 = acc[ai][bj][2 * mp][n] * r0, v1 = acc[ai][bj][2 * mp + 1][n] * r1;
                        v4u w; w.x = pg8::cvt_pk_bf16(v0[0], v0[1]); w.y = pg8::cvt_pk_bf16(v0[2], v0[3]); w.z = pg8::cvt_pk_bf16(v1[0], v1[1]); w.w = pg8::cvt_pk_bf16(v1[2], v1[3]);
                        *(v4u*)(CF + (size_t)plane * 4096 + s) = w; } }
    }
};
struct EpiH {
    static constexpr bool PERM_A = false, DUAL = false;
    static constexpr int PERM = 1; static constexpr bool PREFETCH = false; static constexpr int SCALE_A = 0, SCALE_B = 0;
    const bf16* XB; bf16* HB; float* SSP; unsigned char* HB8;
    __device__ __forceinline__ void operator()(const f32x4 (&acc)[2][2][4][2], const pg8::Unit& u, int wr, int wc, int fr, int fq) const {
        const int row0 = u.pm * 256 + wr * 64 + fr, col0 = u.pn * 256 + wc * 32 + 8 * fq;
#pragma unroll
        for (int ai = 0; ai < 2; ++ai)
#pragma unroll
            for (int m = 0; m < 4; ++m) { const int row = row0 + ai * 128 + m * 16; const size_t off = (size_t)row * D + col0; float ss = 0.f;
#pragma unroll
                for (int bj = 0; bj < 2; ++bj) { const v4u xw = __builtin_nontemporal_load((const v4u*)(XB + off + bj * 128));
                    const f32x4 x0 = (f32x4){bflo(xw.x), bfhi(xw.x), bflo(xw.y), bfhi(xw.y)}, x1 = (f32x4){bflo(xw.z), bfhi(xw.z), bflo(xw.w), bfhi(xw.w)};
                    const f32x4 v0 = acc[ai][bj][m][0] + x0, v1 = acc[ai][bj][m][1] + x1;
                    v4u w; w.x = pg8::cvt_pk_bf16(v0[0], v0[1]); w.y = pg8::cvt_pk_bf16(v0[2], v0[3]); w.z = pg8::cvt_pk_bf16(v1[0], v1[1]); w.w = pg8::cvt_pk_bf16(v1[2], v1[3]);
                    const float r0 = bflo(w.x), r1 = bfhi(w.x), r2 = bflo(w.y), r3 = bfhi(w.y), r4 = bflo(w.z), r5 = bfhi(w.z), r6 = bflo(w.w), r7 = bfhi(w.w);
                    ss += ((r0 * r0 + r1 * r1) + (r2 * r2 + r3 * r3)) + ((r4 * r4 + r5 * r5) + (r6 * r6 + r7 * r7));
                    *(v4u*)(HB + off + bj * 128) = w;
                    int q0 = __builtin_amdgcn_cvt_pk_fp8_f32(sat8(r0), sat8(r1), 0, false); q0 = __builtin_amdgcn_cvt_pk_fp8_f32(sat8(r2), sat8(r3), q0, true);
                    int q1 = __builtin_amdgcn_cvt_pk_fp8_f32(sat8(r4), sat8(r5), 0, false); q1 = __builtin_amdgcn_cvt_pk_fp8_f32(sat8(r6), sat8(r7), q1, true);
                    *(v2u*)(HB8 + off + bj * 128) = (v2u){(unsigned)q0, (unsigned)q1}; }
                ss = xor32_sum(xor16_sum(ss));
                if (fq == 0) SSP[(size_t)row * 16 + u.pn * 4 + wc] = ss; }
    }
};
struct EpiGU {
    static constexpr bool PERM_A = false, DUAL = false;
    static constexpr int PERM = 1; static constexpr bool PREFETCH = false;
    static constexpr int SCALE_A = 0x7F7F7F7F, SCALE_B = 0x79797979;
    const float* rsl; const float* rstd2; unsigned char* hact; const volatile LAS int* bst;
    __device__ __forceinline__ void operator()(const f32x4 (&acc)[2][2][4][2], const pg8::Unit& u, int wr, int wc, int fr, int fq) const {
        const int blk = bst[u.e] + u.pm; unsigned char* H = hact + (size_t)blk * 65536;
        const int col0 = u.pn * 128 + wc * 32 + 8 * fq;
        const float* rp = (u.e < 64) ? rsl + (size_t)u.e * 32768 + u.pm * 256 : rstd2 + u.pm * 256;
        float rsv[8];
#pragma unroll
        for (int q = 0; q < 8; ++q) rsv[q] = rp[(q >> 2) * 128 + wr * 64 + (q & 3) * 16 + fr];
#pragma unroll
        for (int ai = 0; ai < 2; ++ai)
#pragma unroll
            for (int m = 0; m < 4; ++m) { const int r = ai * 128 + wr * 64 + m * 16 + fr;
                const float rs = rsv[ai * 4 + m];
                const f32x4 g0 = acc[ai][0][m][0] * rs, g1 = acc[ai][0][m][1] * rs, u0 = acc[ai][1][m][0] * (rs * HSCALE), u1 = acc[ai][1][m][1] * (rs * HSCALE);
                float hv[8];
#pragma unroll
                for (int j = 0; j < 4; ++j) { hv[j] = sat8(g0[j] * __builtin_amdgcn_rcpf(1.0f + __builtin_amdgcn_exp2f(-1.44269504f * g0[j])) * u0[j]); hv[4 + j] = sat8(g1[j] * __builtin_amdgcn_rcpf(1.0f + __builtin_amdgcn_exp2f(-1.44269504f * g1[j])) * u1[j]); }
                int p0 = __builtin_amdgcn_cvt_pk_fp8_f32(hv[0], hv[1], 0, false); p0 = __builtin_amdgcn_cvt_pk_fp8_f32(hv[2], hv[3], p0, true);
                int p1 = __builtin_amdgcn_cvt_pk_fp8_f32(hv[4], hv[5], 0, false); p1 = __builtin_amdgcn_cvt_pk_fp8_f32(hv[6], hv[7], p1, true);
                *(v2u*)(H + (size_t)r * 256 + col0) = (v2u){(unsigned)p0, (unsigned)p1}; }
    }
};
struct EpiDN {
    static constexpr int PERM = 2;
    static constexpr bool PREFETCH = false; static constexpr int SCALE_A = 0x7C7C7C7C, SCALE_B = 0x79797979;
    const int* list; const float* gates; unsigned char* contrib; unsigned char* contrib9; unsigned char* trash;
    __device__ __forceinline__ void prefetch(const pg8::Unit& u, int wr, int fr, int fq, unsigned (&sgq)[2]) const {
        const unsigned* lp = (const unsigned*)list + (size_t)(u.e < 64 ? u.e : 0) * 32768 + u.pm * 256;
        sgq[0] = lp[wr * 64 + fq * 16 + fr]; sgq[1] = lp[128 + wr * 64 + fq * 16 + fr];
    }
    __device__ __forceinline__ void operator()(const f32x4 (&acc)[2][2][4][2], const pg8::Unit& u, int wr, int wc, int fr, int fq) const {
        unsigned sgp[8];
        { const unsigned* lp = (const unsigned*)list + (size_t)(u.e < 64 ? u.e : 0) * 32768 + u.pm * 256;
#pragma unroll
          for (int q = 0; q < 8; ++q) sgp[q] = lp[(q >> 2) * 128 + wr * 64 + (q & 3) * 16 + fr]; }
        const int col0 = u.pn * 256 + wc * 32 + 16 * (fq & 1) + 128 * (fq >> 1); const bool routed = u.e < 64;
#pragma unroll
        for (int ai = 0; ai < 2; ++ai) {
#pragma unroll
            for (int m = 0; m < 4; ++m) { const int r = ai * 128 + wr * 64 + m * 16 + fr; const float gs = routed ? (float)(sgp[ai * 4 + m] & 16383u) * (2.5f * CSCALE / 16383.0f) : CSCALE;
                unsigned char* cp = routed ? contrib + (size_t)(sgp[ai * 4 + m] >> 14) * 1024 : contrib9 + (size_t)(u.pm * 256 + r) * 1024;
                cp = (r < u.nvalid) ? cp : trash; cp += col0;
                unsigned pk[2][2];
#pragma unroll
                for (int bj = 0; bj < 2; ++bj) { const f32x4 v0 = acc[ai][bj][m][0] * gs, v1 = acc[ai][bj][m][1] * gs;
                    int p0 = __builtin_amdgcn_cvt_pk_fp8_f32(v0[0], v0[1], 0, false); p0 = __builtin_amdgcn_cvt_pk_fp8_f32(v0[2], v0[3], p0, true);
                    int p1 = __builtin_amdgcn_cvt_pk_fp8_f32(v1[0], v1[1], 0, false); p1 = __builtin_amdgcn_cvt_pk_fp8_f32(v1[2], v1[3], p1, true);
                    pk[bj][0] = (unsigned)p0; pk[bj][1] = (unsigned)p1; }
                const auto s0 = __builtin_amdgcn_permlane32_swap(pk[0][0], pk[1][0], false, false);
                const auto s1 = __builtin_amdgcn_permlane32_swap(pk[0][1], pk[1][1], false, false);
                *(v4u*)cp = (v4u){s0[0], s1[0], s0[1], s1[1]}; }
            asm volatile("" ::: "memory"); }
    }
};

__device__ __forceinline__ void p0_transpose_item(const float* W, int K, int N, bf16* WT, int row_off_n0, const float* ksc, LAS float* scr, int kb, int nb, int) {
    const int lane = lane_id();
    const int k0 = 64 * kb, n0 = 32 * nb;
    { f32x4 ld[8];
#pragma unroll
      for (int i = 0; i < 8; ++i) ld[i] = __builtin_nontemporal_load((const f32x4*)(W + (size_t)(k0 + 8 * i + (lane >> 3)) * N + n0 + 4 * (lane & 7)));
#pragma unroll
      for (int i = 0; i < 8; ++i) { LAS float* d_ = scr + (8 * i + (lane >> 3)) * 33 + 4 * (lane & 7); d_[0] = ld[i].x; d_[1] = ld[i].y; d_[2] = ld[i].z; d_[3] = ld[i].w; } }
    LDS_WAIT(); asm volatile("" ::: "memory");
    const int c = lane & 7;
    float sc[8];
#pragma unroll
    for (int q = 0; q < 8; ++q) sc[q] = ksc ? ksc[k0 + 8 * c + q] : 1.0f;
#pragma unroll
    for (int j = 0; j < 4; ++j) { const int n = (lane >> 3) + 8 * j; const LAS float* s = scr + (8 * c) * 33 + n;
        v4u o; o.x = pk2(s[0 * 33] * sc[0], s[1 * 33] * sc[1]); o.y = pk2(s[2 * 33] * sc[2], s[3 * 33] * sc[3]); o.z = pk2(s[4 * 33] * sc[4], s[5 * 33] * sc[5]); o.w = pk2(s[6 * 33] * sc[6], s[7 * 33] * sc[7]);
        *(v4u*)(WT + (size_t)(row_off_n0 + n) * K + k0 + 8 * c) = o; }
    LDS_WAIT(); asm volatile("" ::: "memory");
}
__device__ __forceinline__ void p0_transpose_item8(const float* W, int K, int N, unsigned char* WT, int row_off_n0, const float* ksc, LAS float* scr, int kb, int nb, int) {
    const int lane = lane_id();
    const int k0 = 128 * kb, n0 = 32 * nb;
    { f32x4 ld[16];
#pragma unroll
      for (int i = 0; i < 16; ++i) ld[i] = __builtin_nontemporal_load((const f32x4*)(W + (size_t)(k0 + 8 * i + (lane >> 3)) * N + n0 + 4 * (lane & 7)));
#pragma unroll
      for (int i = 0; i < 16; ++i) { const int kk = 8 * i + (lane >> 3), c = 4 * (lane & 7), x_ = kk & 31;
          scr[kk * 32 + ((c + 0) ^ x_)] = ld[i].x; scr[kk * 32 + ((c + 1) ^ x_)] = ld[i].y; scr[kk * 32 + ((c + 2) ^ x_)] = ld[i].z; scr[kk * 32 + ((c + 3) ^ x_)] = ld[i].w; } }
    LDS_WAIT(); asm volatile("" ::: "memory");
    const int c8 = lane & 7;
    float sc[16];
#pragma unroll
    for (int q = 0; q < 16; ++q) sc[q] = (ksc ? ksc[k0 + 16 * c8 + q] : 1.0f) * WSCALE;
#pragma unroll 1
    for (int j = 0; j < 4; ++j) { const int n = (lane >> 3) + 8 * j; float v[16];
#pragma unroll
        for (int q = 0; q < 16; ++q) { const int kk = 16 * c8 + q; v[q] = scr[kk * 32 + (n ^ (kk & 31))] * sc[q]; }
        unsigned w[4];
#pragma unroll
        for (int q = 0; q < 4; ++q) { int p = __builtin_amdgcn_cvt_pk_fp8_f32(v[4 * q], v[4 * q + 1], 0, false); p = __builtin_amdgcn_cvt_pk_fp8_f32(v[4 * q + 2], v[4 * q + 3], p, true); w[q] = (unsigned)p; }
        *(v4u*)(WT + (size_t)(row_off_n0 + n) * K + k0 + 16 * c8) = (v4u){w[0], w[1], w[2], w[3]}; }
    LDS_WAIT(); asm volatile("" ::: "memory");
}
__device__ __forceinline__ void p0_prologue(Frame& F) {
    LAS float* scr = (LAS float*)(F.lds + F.wave * 16384);
    const int gw = F.c * NWAVES + F.wave, NGW = F.G * NWAVES, lane = lane_id();
    constexpr int I_IN = 16 * 32, I_OUT = 16 * 32, I_R = 16 * 2, I_G = 64 * 64, I_D = 64 * 64, I_S = 64, I_F = 8 * 64;
    constexpr int NITEMS = I_IN + I_OUT + I_R + 2 * I_G + I_D + 3 * I_S + I_F;
    unsigned char* WguT = WSP(unsigned char, WS_WGU); unsigned char* WdT = WSP(unsigned char, WS_WD);
    for (int it = gw; it < NITEMS; it += NGW) {
        int r = it;
        if (r < I_IN) { p0_transpose_item(karg_in(2), 1024, 1536, WSP(bf16, WS_WIN), (r & 31) * 32, karg_in(1), scr, r >> 5, r & 31, lane); continue; } r -= I_IN;
        if (r < I_OUT) { p0_transpose_item(karg_in(9), 1024, 1024, WSP(bf16, WS_WOUT), (r % 32) * 32, nullptr, scr, r / 32, r % 32, lane); continue; } r -= I_OUT;
        if (r < I_R) { p0_transpose_item(karg_in(11), 1024, 64, WSP(bf16, WS_WR), (r % 2) * 32, karg_in(10), scr, r / 2, r % 2, lane); continue; } r -= I_R;
        if (r < 2 * I_G) { const int up = r >= I_G; if (up) r -= I_G; const int e = r >> 6, q = r & 63, kb = q >> 3, nb = q & 7, n0 = nb * 32;
            p0_transpose_item8((up ? karg_in(14) : karg_in(13)) + (size_t)e * 1024 * 256, 1024, 256, WguT + (size_t)e * 512 * 1024, (n0 >> 7) * 256 + up * 128 + (n0 & 127), karg_in(10), scr, kb, nb, lane); continue; } r -= 2 * I_G;
        if (r < I_D) { const int e = r >> 6, q = r & 63, kb = q >> 5, nb = q & 31;
            p0_transpose_item8(karg_in(15) + (size_t)e * 256 * 1024, 256, 1024, WdT + (size_t)e * 1024 * 256, nb * 32, nullptr, scr, kb, nb, lane); continue; } r -= I_D;
        if (r < 2 * I_S) { const int up = r >= I_S; if (up) r -= I_S; const int kb = r >> 3, nb = r & 7, n0 = nb * 32;
            p0_transpose_item8(up ? karg_in(17) : karg_in(16), 1024, 256, WguT + (size_t)64 * 512 * 1024, (n0 >> 7) * 256 + up * 128 + (n0 & 127), karg_in(10), scr, kb, nb, lane); continue; } r -= 2 * I_S;
        if (r < I_S) { const int kb = r >> 5, nb = r & 31; p0_transpose_item8(karg_in(18), 256, 1024, WdT + (size_t)64 * 1024 * 256, nb * 32, nullptr, scr, kb, nb, lane); continue; } r -= I_S;
        {
            const int g = r >> 6, k0 = 16 * (r & 63), n0 = 1024 + 64 * g, ln2 = lane_id();
            const float* src = karg_in(2) + (size_t)k0 * 1536 + n0 + ln2; const float* g1 = karg_in(1) + k0;
            float xv[16];
#pragma unroll
            for (int i = 0; i < 16; ++i) xv[i] = src[(size_t)i * 1536];
            { float sn, cs; sincospif((float)ln2 * (1.0f / 32.0f), &sn, &cs); scr[1024 + ln2] = cs; scr[1088 + ln2] = sn; }
#pragma unroll
            for (int p = 0; p < 4; ++p) *(LAS f32x4*)(scr + ln2 * 16 + 4 * p) = (f32x4){xv[4 * p] * g1[4 * p], xv[4 * p + 1] * g1[4 * p + 1], xv[4 * p + 2] * g1[4 * p + 2], xv[4 * p + 3] * g1[4 * p + 3]};
            LDS_WAIT(); asm volatile("" ::: "memory");
            const int mm = ln2 <= 32 ? ln2 : ln2 - 32;
            float o[16];
#pragma unroll
            for (int q = 0; q < 16; ++q) o[q] = 0.f;
#pragma unroll 8
            for (int c = 0; c < 64; ++c) { const int ix = (mm * c) & 63; const float cs = scr[1024 + ix], sn = scr[1088 + ix]; const float tmc = ln2 <= 32 ? cs : -sn;
#pragma unroll
                for (int p = 0; p < 4; ++p) { const f32x4 rv = *(const LAS f32x4*)(scr + c * 16 + 4 * p); o[4 * p] += rv.x * tmc; o[4 * p + 1] += rv.y * tmc; o[4 * p + 2] += rv.z * tmc; o[4 * p + 3] += rv.w * tmc; } }
            bf16* dst = WSP(bf16, WS_WIN) + (size_t)(n0 + ln2) * 1024 + k0;
            *(v4u*)dst = (v4u){pk2(o[0], o[1]), pk2(o[2], o[3]), pk2(o[4], o[5]), pk2(o[6], o[7])};
            *(v4u*)(dst + 8) = (v4u){pk2(o[8], o[9]), pk2(o[10], o[11]), pk2(o[12], o[13]), pk2(o[14], o[15])};
            LDS_WAIT(); asm volatile("" ::: "memory");
        }
    }
    bf16* XN = WSP(bf16, WS_XN);
    float* RSTD1 = WSP(float, WS_RSTD1);
    for (int m0 = gw * 2; m0 < T; m0 += NGW * 2) {
        f32x4 v[2][4];
#pragma unroll
        for (int r = 0; r < 2; ++r) { const f32x4* xr = (const f32x4*)(karg_in(0) + (size_t)(m0 + r) * D) + lane;
#pragma unroll
            for (int j = 0; j < 4; ++j) v[r][j] = __builtin_nontemporal_load(xr + 64 * j); }
#pragma unroll
        for (int r = 0; r < 2; ++r) { float sq = 0.f; unsigned long long* o8 = (unsigned long long*)(XN + (size_t)(m0 + r) * D) + lane;
#pragma unroll
            for (int j = 0; j < 4; ++j) { sq += (v[r][j].x * v[r][j].x + v[r][j].y * v[r][j].y) + (v[r][j].z * v[r][j].z + v[r][j].w * v[r][j].w);
                o8[64 * j] = (unsigned long long)pk2(v[r][j].x, v[r][j].y) | ((unsigned long long)pk2(v[r][j].z, v[r][j].w) << 32); }
            const float rstd = 1.0f / sqrtf(wave_sum(sq) * (1.f / D) + EPS);
            if (lane == 0) RSTD1[m0 + r] = rstd; }
    }
    const int gt = F.c * 512 + (F.wave * 64 + lane_id()), NGT = F.G * 512;
    bf16* WSB = WSP(bf16, WS_WSB);
    for (int i = gt; i < 8 * 128 * 128; i += NGT) WSB[i] = (bf16)f2bf(karg_in(5)[i]);
    { unsigned char* IMG = WSP(unsigned char, WS_F2IMG);
      for (int i = gt; i < 128 * 128 + 64 * 128 + 2048; i += NGT) {
        if (i < 128 * 128) { const int r = i >> 7, c = i & 127, pp = r >> 6, k1 = r & 63, p = c >> 6, s1 = c & 63; float sn, cs; sincospif((float)((k1 * s1) & 63) * (1.0f / 32.0f), &sn, &cs);
            const float v = pp == 0 ? (p == 0 ? cs : sn) : (p == 0 ? -sn : cs); *(bf16*)(IMG + FB_OFF + r * FPITCH + c * 2) = (bf16)f2bf(v); }
        else if (i < 128 * 128 + 64 * 128) { const int j = i - 128 * 128, k2 = j >> 7, c = j & 127, p = c >> 6, s2 = c & 63; float sn, cs; sincospif((float)((k2 * s2) & 63) * (1.0f / 32.0f), &sn, &cs);
            *(bf16*)(IMG + GT_OFF + k2 * FPITCH + c * 2) = (bf16)f2bf(p == 0 ? cs : sn); }
        else { const int j = i - 128 * 128 - 64 * 128; float sn, cs; sincospif((float)j * (2.0f / 4096.0f), &sn, &cs); *(f32x2*)(IMG + TWL_OFF + j * 8) = (f32x2){cs, -sn}; } } }
    { bf16* CF = WSP(bf16, WS_CF);
      for (int i = gt; i < 64 * 2 * 512; i += NGT) { const int bg = i >> 10, m = ((i >> 9) & 1) * 32, o = i & 511; *(v4u*)(CF + ((size_t)(bg * 33 + m) * 2 + 1) * 4096 + o * 8) = (v4u){0u, 0u, 0u, 0u}; } }
    f32x2* TW = WSP(f32x2, WS_TW);
    for (int i = gt; i < 2048 + 64; i += NGT) {
        if (i < 2048) { float s, c; sincospif((float)i * (2.0f / 4096.0f), &s, &c); TW[i] = (f32x2){c, -s}; }
        else { const int j = i - 2048; float s, c; sincospif((float)j * (2.0f / 64.0f), &s, &c); TW[2048 + j] = (f32x2){c, s}; }
    }
}

constexpr int VN_PITCH = 272;
__host__ __device__ __forceinline__ int sgu_row(int c) { return 16 * (2 * (c >> 5) + ((c >> 2) & 1)) + 4 * ((c >> 3) & 3) + (c & 3); }
__device__ __forceinline__ void sgu_item(Frame& F, int item) {
    const int t0 = item * 128, lane = lane_id(), h = F.wave, fr = lane & 15, fq = lane >> 4;
    const bf16* Z = WSP(const bf16, WS_Z) + (size_t)t0 * DIN;
    LAS unsigned char* vnT = F.lds;
    LAS float* ssq = (LAS float*)(F.lds + 512 * VN_PITCH + 1024);
    { v4u wv[16];
#pragma unroll
      for (int r = 0; r < 16; ++r) wv[r] = __builtin_nontemporal_load((const v4u*)(Z + (size_t)(16 * h + r) * DIN + 512 + lane * 8));
      float gch[8], bch[8];
      { const f32x4 ga = *(const f32x4*)(karg_in(3) + lane * 8), gb = *(const f32x4*)(karg_in(3) + lane * 8 + 4), ba = *(const f32x4*)(karg_in(4) + lane * 8), bb = *(const f32x4*)(karg_in(4) + lane * 8 + 4);
        gch[0] = ga.x; gch[1] = ga.y; gch[2] = ga.z; gch[3] = ga.w; gch[4] = gb.x; gch[5] = gb.y; gch[6] = gb.z; gch[7] = gb.w;
        bch[0] = ba.x; bch[1] = ba.y; bch[2] = ba.z; bch[3] = ba.w; bch[4] = bb.x; bch[5] = bb.y; bch[6] = bb.z; bch[7] = bb.w; }
#pragma unroll
      for (int rb = 0; rb < 2; ++rb) { unsigned o[8][4];
#pragma unroll
        for (int rr = 0; rr < 8; ++rr) { const v4u w = wv[rb * 8 + rr];
            float v[8] = {bflo(w.x), bfhi(w.x), bflo(w.y), bfhi(w.y), bflo(w.z), bfhi(w.z), bflo(w.w), bfhi(w.w)}; float s1 = 0.f;
#pragma unroll
            for (int j = 0; j < 8; ++j) s1 += v[j];
            const float mean = wave_sum(s1) * (1.f / 512.f); float s2 = 0.f;
#pragma unroll
            for (int j = 0; j < 8; ++j) { v[j] -= mean; s2 += v[j] * v[j]; }
            const float rstd = 1.0f / sqrtf(wave_sum(s2) * (1.f / 512.f) + EPS);
#pragma unroll
            for (int j = 0; j < 8; ++j) { const unsigned bits = f2bf(v[j] * rstd * gch[j] + bch[j]); if (rr & 1) o[j][rr >> 1] |= bits << 16; else o[j][rr >> 1] = bits; } }
        const int hh = lane >> 3, cl = (lane & 7) * 8;
#pragma unroll
        for (int j = 0; j < 8; ++j) *(LAS v4u*)(vnT + (hh * 64 + sgu_row(cl + j)) * VN_PITCH + (16 * h + rb * 8) * 2) = (v4u){o[j][0], o[j][1], o[j][2], o[j][3]}; } }
    LDS_BARRIER();
    const bf16* WSB = WSP(const bf16, WS_WSB) + (size_t)h * 128 * 128;
    bf16* MIX = WSP(bf16, WS_MIX) + (size_t)t0 * D;
    bf16x8 Xf[4][4];
#pragma unroll
    for (int ks = 0; ks < 4; ++ks)
#pragma unroll
        for (int dt = 0; dt < 4; ++dt) Xf[ks][dt] = *(const LAS bf16x8*)(vnT + (h * 64 + dt * 16 + fr) * VN_PITCH + (ks * 32 + fq * 8) * 2);
    unsigned ypk[8][8];
    bf16x8 Yc[4], Yn[4]; v4u uc[2], un[2];
#pragma unroll
    for (int ks = 0; ks < 4; ++ks) Yc[ks] = *(const bf16x8*)(WSB + (size_t)fr * 128 + ks * 32 + fq * 8);
#pragma unroll
    for (int t = 0; t < 2; ++t) uc[t] = __builtin_nontemporal_load((const v4u*)(Z + (size_t)fr * DIN + h * 64 + 32 * t + 8 * fq));
#pragma unroll
    for (int pt = 0; pt < 8; ++pt) {
        if (pt < 7) {
#pragma unroll
            for (int ks = 0; ks < 4; ++ks) Yn[ks] = *(const bf16x8*)(WSB + (size_t)((pt + 1) * 16 + fr) * 128 + ks * 32 + fq * 8);
#pragma unroll
            for (int t = 0; t < 2; ++t) un[t] = __builtin_nontemporal_load((const v4u*)(Z + (size_t)((pt + 1) * 16 + fr) * DIN + h * 64 + 32 * t + 8 * fq)); }
        f32x4 acc[4];
#pragma unroll
        for (int dt = 0; dt < 4; ++dt) acc[dt] = (f32x4){0.f, 0.f, 0.f, 0.f};
#pragma unroll
        for (int ks = 0; ks < 4; ++ks) {
#pragma unroll
            for (int dt = 0; dt < 4; ++dt) acc[dt] = __builtin_amdgcn_mfma_f32_16x16x32_bf16(Xf[ks][dt], Yc[ks], acc[dt], 0, 0, 0); }
        const int p = pt * 16 + fr; const float bias = karg_in(6)[h * 128 + p]; float ss = 0.f;
#pragma unroll
        for (int t = 0; t < 2; ++t) { const v4u uw = uc[t]; const f32x4 a0 = acc[2 * t], a1 = acc[2 * t + 1];
            const float y0 = bflo(uw.x) * (a0[0] + bias), y1 = bfhi(uw.x) * (a0[1] + bias), y2 = bflo(uw.y) * (a0[2] + bias), y3 = bfhi(uw.y) * (a0[3] + bias);
            const float y4 = bflo(uw.z) * (a1[0] + bias), y5 = bfhi(uw.z) * (a1[1] + bias), y6 = bflo(uw.w) * (a1[2] + bias), y7 = bfhi(uw.w) * (a1[3] + bias);
            ss += ((y0 * y0 + y1 * y1) + (y2 * y2 + y3 * y3)) + ((y4 * y4 + y5 * y5) + (y6 * y6 + y7 * y7));
            ypk[pt][4 * t + 0] = pk2(y0, y1); ypk[pt][4 * t + 1] = pk2(y2, y3); ypk[pt][4 * t + 2] = pk2(y4, y5); ypk[pt][4 * t + 3] = pk2(y6, y7); }
        ss = xor32_sum(xor16_sum(ss)); if (fq == 0) ssq[p * 8 + h] = ss;
        __builtin_amdgcn_sched_barrier(0);
#pragma unroll
        for (int ks = 0; ks < 4; ++ks) Yc[ks] = Yn[ks];
        uc[0] = un[0]; uc[1] = un[1];
    }
    LDS_BARRIER();
#pragma unroll
    for (int pt = 0; pt < 8; ++pt) { const int p = pt * 16 + fr; float tot = 0.f;
#pragma unroll
        for (int j = 0; j < 8; ++j) tot += ssq[p * 8 + j];
        const float rstd = 1.0f / sqrtf(tot * (1.f / 512.f) + EPS);
#pragma unroll
        for (int t = 0; t < 2; ++t) { const int ch = h * 64 + 32 * t + 8 * fq; const f32x4 g0 = *(const f32x4*)(karg_in(7) + ch), g1 = *(const f32x4*)(karg_in(7) + ch + 4);
            const unsigned w0 = ypk[pt][4 * t], w1 = ypk[pt][4 * t + 1], w2 = ypk[pt][4 * t + 2], w3 = ypk[pt][4 * t + 3];
            *(v4u*)(MIX + (size_t)p * D + ch) = (v4u){pk2(bflo(w0) * rstd * g0.x, bfhi(w0) * rstd * g0.y), pk2(bflo(w1) * rstd * g0.z, bfhi(w1) * rstd * g0.w),
                                                     pk2(bflo(w2) * rstd * g1.x, bfhi(w2) * rstd * g1.y), pk2(bflo(w3) * rstd * g1.z, bfhi(w3) * rstd * g1.w)}; } }
    LDS_BARRIER();
}
__device__ __forceinline__ void f1_item(Frame& F, int item) {
    const int t0 = item * 64, b = t0 >> 12, s0 = t0 & 4095, tid = (F.wave * 64 + lane_id()), lane = lane_id(), g = F.wave;
    const bf16* Z = WSP(const bf16, WS_Z) + (size_t)t0 * DIN + 1024;
    LAS float* zt = (LAS float*)F.lds;
#pragma unroll
    for (int i = 0; i < 8; ++i) { const int idx = tid + 512 * i, tok = idx >> 6, c8 = idx & 63; const v4u w = __builtin_nontemporal_load((const v4u*)(Z + (size_t)tok * DIN + c8 * 8)); LAS float* d = zt + tok * 513 + c8 * 8;
        d[0] = bflo(w.x); d[1] = bfhi(w.x); d[2] = bflo(w.y); d[3] = bfhi(w.y); d[4] = bflo(w.z); d[5] = bfhi(w.z); d[6] = bflo(w.w); d[7] = bfhi(w.w); }
    LDS_BARRIER();
    bf16* CF = WSP(bf16, WS_CF) + ((size_t)(b * 8 + g) * 33) * 8192 + s0 + lane;
    const LAS float* zr = zt + lane * 513 + g * 64;
#pragma unroll
    for (int m = 0; m <= 32; ++m) { const float re = zr[m], im = (m >= 1 && m <= 31) ? zr[32 + m] : 0.f; CF[(size_t)m * 8192] = (bf16)f2bf(re); CF[(size_t)m * 8192 + 4096] = (bf16)f2bf(im); }
    LDS_BARRIER();
}
typedef short s16x4 __attribute__((ext_vector_type(4)));
__device__ __forceinline__ void f2_phase(Frame& F) {
    LAS unsigned char* L = F.lds; const int tid = (F.wave * 64 + lane_id()), lane = lane_id(), wave = F.wave, l15 = lane & 15, kg = lane >> 4;
    { const v4u* IMG = WSP(const v4u, WS_F2IMG); for (int i = tid; i < XI_OFF / 16; i += 512) *(LAS v4u*)(L + i * 16) = IMG[i]; }
    const LAS f32x2* TWL = (const LAS f32x2*)(L + TWL_OFF);
    const bf16* CF = WSP(const bf16, WS_CF);
    int col = F.c; v4u pre[2];
    if (col < NCOLF) { pre[0] = __builtin_nontemporal_load((const v4u*)(CF + (size_t)col * 8192 + tid * 8)); pre[1] = __builtin_nontemporal_load((const v4u*)(CF + (size_t)col * 8192 + 4096 + tid * 8)); }
    LDS_BARRIER();
    const int mt = wave & 3, pg = wave >> 2;
    for (int buf = 0; col < NCOLF; col += F.G, buf ^= 1) {
        LAS unsigned char* XI = L + XI_OFF + buf * XI_SZ;
        *(LAS v4u*)(XI + (tid >> 3) * XPITCH + (tid & 7) * 16) = pre[0]; *(LAS v4u*)(XI + (64 + (tid >> 3)) * XPITCH + (tid & 7) * 16) = pre[1];
        if (col + F.G < NCOLF) { pre[0] = __builtin_nontemporal_load((const v4u*)(CF + (size_t)(col + F.G) * 8192 + tid * 8)); pre[1] = __builtin_nontemporal_load((const v4u*)(CF + (size_t)(col + F.G) * 8192 + 4096 + tid * 8)); }
        LDS_BARRIER();
        f32x4 acc[2][2];
#pragma unroll
        for (int a_ = 0; a_ < 2; ++a_)
#pragma unroll
            for (int b_ = 0; b_ < 2; ++b_) acc[a_][b_] = (f32x4){0.f, 0.f, 0.f, 0.f};
#pragma unroll
        for (int ks = 0; ks < 4; ++ks) {
            const int rowb = ks * 32 + 8 * kg + (l15 >> 2), colb = 16 * mt + 4 * (lane & 3);
            const s16x4 alo = __builtin_amdgcn_ds_read_tr16_b64_v4i16((LAS s16x4*)(XI + rowb * XPITCH + colb * 2));
            const s16x4 ahi = __builtin_amdgcn_ds_read_tr16_b64_v4i16((LAS s16x4*)(XI + (rowb + 4) * XPITCH + colb * 2));
            const bf16x8 A = __builtin_shufflevector(alo, ahi, 0, 1, 2, 3, 4, 5, 6, 7);
#pragma unroll
            for (int kt = 0; kt < 2; ++kt)
#pragma unroll
                for (int part = 0; part < 2; ++part) { const int jrow = part * 64 + (2 * pg + kt) * 16 + l15;
                    const bf16x8 B = *(const LAS bf16x8*)(L + FB_OFF + jrow * FPITCH + (ks * 32 + 8 * kg) * 2);
                    acc[kt][part] = __builtin_amdgcn_mfma_f32_16x16x32_bf16(A, B, acc[kt][part], 0, 0, 0); }
        }
#pragma unroll
        for (int kt = 0; kt < 2; ++kt) { const int k1 = (2 * pg + kt) * 16 + l15, s2b = 16 * mt + 4 * kg; float tr4[4], ti4[4];
#pragma unroll
            for (int r = 0; r < 4; ++r) { const int idx = k1 * (s2b + r); f32x2 w = TWL[idx & 2047]; if (idx >= 2048) w = -w;
                const float tr = acc[kt][0][r], ti = acc[kt][1][r]; tr4[r] = tr * w.x - ti * w.y; ti4[r] = tr * w.y + ti * w.x; }
            *(LAS v2u*)(L + TI_OFF + k1 * FPITCH + s2b * 2) = (v2u){pk2(tr4[0], tr4[1]), pk2(tr4[2], tr4[3])};
            *(LAS v2u*)(L + TI_OFF + k1 * FPITCH + (64 + s2b) * 2) = (v2u){pk2(ti4[0], ti4[1]), pk2(ti4[2], ti4[3])}; }
        LDS_BARRIER();
        f32x4 acc2[2] = {(f32x4){0.f, 0.f, 0.f, 0.f}, (f32x4){0.f, 0.f, 0.f, 0.f}};
#pragma unroll
        for (int ks = 0; ks < 4; ++ks) { const bf16x8 G2 = *(const LAS bf16x8*)(L + GT_OFF + (16 * mt + l15) * FPITCH + (ks * 32 + 8 * kg) * 2);
#pragma unroll
            for (int j = 0; j < 2; ++j) { const bf16x8 T2 = *(const LAS bf16x8*)(L + TI_OFF + ((2 * pg + j) * 16 + l15) * FPITCH + (ks * 32 + 8 * kg) * 2);
                acc2[j] = __builtin_amdgcn_mfma_f32_16x16x32_bf16(T2, G2, acc2[j], 0, 0, 0); } }
        float* dst = WSP(float, WS_YT) + (size_t)col * 4096;
#pragma unroll
        for (int j = 0; j < 2; ++j) *(f32x4*)(dst + (16 * mt + l15) * 64 + (2 * pg + j) * 16 + 4 * kg) = acc2[j] * (1.0f / 512.0f);
    }
    LDS_BARRIER();
}
__device__ __forceinline__ void f3_item(Frame& F, int item) {
    const int t0 = item * 64, b = t0 >> 12, k0 = t0 & 4095, lane = lane_id(), g = F.wave;
    LAS float* yt = (LAS float*)F.lds;
    const float* YT = WSP(const float, WS_YT) + ((size_t)(b * 8 + g) * 33) * 4096;
    { const int tq = lane & 15, cs = lane >> 4;
#pragma unroll
      for (int mb = 0; mb < 36; mb += 12) { f32x4 v[3], v2[3];
#pragma unroll
        for (int i = 0; i < 3; ++i) { const int m = mb + 4 * i + cs;
            const int mc = m <= 32 ? m : 32;
            v[i] = __builtin_nontemporal_load((const f32x4*)(YT + (size_t)mc * 4096 + k0 + 4 * tq));
            const int kb = 4096 - k0 - 4 * tq - 3;
            if (k0 + tq != 0) v2[i] = __builtin_nontemporal_load((const f32x4*)(YT + (size_t)mc * 4096 + kb));
            else { const float* yp = YT + (size_t)mc * 4096; v2[i] = (f32x4){yp[4093], yp[4094], yp[4095], yp[0]}; } }
#pragma unroll
        for (int i = 0; i < 3; ++i) { const int m = mb + 4 * i + cs;
            if (m <= 32) { LAS float* d_ = yt + (4 * tq) * 513 + g * 64 + m; d_[0] = v[i].x; d_[513] = v[i].y; d_[2 * 513] = v[i].z; d_[3 * 513] = v[i].w;
                if (m >= 1 && m <= 31) { LAS float* e_ = yt + (4 * tq) * 513 + g * 64 + 64 - m; e_[0] = v2[i].w; e_[513] = v2[i].z; e_[2 * 513] = v2[i].y; e_[3 * 513] = v2[i].x; } } } } }
    LDS_BARRIER();
    bf16* MIX = WSP(bf16, WS_MIX) + (size_t)t0 * D + 512;
    for (int r = 0; r < 8; ++r) { const int row = F.wave * 8 + r; float ss = 0.f;
#pragma unroll
        for (int j = 0; j < 8; ++j) { const float v = yt[row * 513 + lane + 64 * j]; ss += v * v; }
        const float rstd = 1.0f / sqrtf(wave_sum(ss) * (1.f / 512.f) + EPS);
        float v[8];
#pragma unroll
        for (int j = 0; j < 8; ++j) v[j] = yt[row * 513 + lane * 8 + j] * rstd * karg_in(8)[lane * 8 + j];
        *(v4u*)(MIX + (size_t)row * D + lane * 8) = (v4u){pk2(v[0], v[1]), pk2(v[2], v[3]), pk2(v[4], v[5]), pk2(v[6], v[7])}; }
    LDS_BARRIER();
}

constexpr int WR_PITCH = 2064;
__device__ __forceinline__ float red16_max(float v) { v = fmaxf(v, dpp_f<0xB1>(v)); v = fmaxf(v, dpp_f<0x4E>(v)); v = fmaxf(v, dpp_f<0x141>(v)); v = fmaxf(v, dpp_f<0x140>(v)); return v; }
__device__ __forceinline__ int red16_min(int v) { v = min(v, dpp_i<0xB1>(v)); v = min(v, dpp_i<0x4E>(v)); v = min(v, dpp_i<0x141>(v)); v = min(v, dpp_i<0x140>(v)); return v; }
__device__ __forceinline__ float red8_max(float v) { v = fmaxf(v, dpp_f<0xB1>(v)); v = fmaxf(v, dpp_f<0x4E>(v)); v = fmaxf(v, dpp_f<0x141>(v)); return v; }
__device__ __forceinline__ int red8_min(int v) { v = min(v, dpp_i<0xB1>(v)); v = min(v, dpp_i<0x4E>(v)); v = min(v, dpp_i<0x141>(v)); return v; }
__device__ __forceinline__ float red16_sum(float v) { return row16_sum(v); }
__device__ __forceinline__ void route_phase(Frame& F) {
    const int tid = (F.wave * 64 + lane_id()), lane = lane_id(), wave = F.wave, c16 = lane & 15, rg = lane >> 4;
    LAS unsigned char* wr = F.lds;
    LAS int* lcnt = (LAS int*)(F.lds + 64 * WR_PITCH);
    LAS int* gbase = lcnt + 64;
    const bf16* WR = WSP(const bf16, WS_WR);
    for (int i = tid; i < 64 * 128; i += 512) { const int e = i >> 7, ch = i & 127; *(LAS v4u*)(wr + e * WR_PITCH + ch * 16) = *(const v4u*)(WR + (size_t)e * 1024 + ch * 8); }
    LDS_BARRIER();
    const bf16* HB = WSP(const bf16, WS_HB); const float* SSP = WSP(const float, WS_SSP);
    float* RSTD2 = WSP(float, WS_RSTD2); float* RSL = WSP(float, WS_RSL); float* GL = WSP(float, WS_GL); int* LIST = WSP(int, WS_LIST); unsigned short* TOKP = WSP(unsigned short, WS_TOKP); unsigned* GCNT = F.ctl + CW_CNT;
    float bias[4];
#pragma unroll
    for (int nt = 0; nt < 4; ++nt) bias[nt] = karg_in(12)[nt * 16 + c16];
    for (int item = F.c; item < T / 128; item += F.G) {
        const int t0 = item * 128 + wave * 16;
        if (tid < 64) lcnt[tid] = 0;
        f32x4 acc[4];
#pragma unroll
        for (int nt = 0; nt < 4; ++nt) acc[nt] = (f32x4){0.f, 0.f, 0.f, 0.f};
        const bf16* arow = HB + (size_t)(t0 + c16) * D + rg * 8;
        v4u a_all[8][4];
#pragma unroll
        for (int blk = 0; blk < 8; ++blk)
#pragma unroll
            for (int s = 0; s < 4; ++s) a_all[blk][s] = __builtin_nontemporal_load((const v4u*)(arow + blk * 128 + s * 32));
#pragma unroll
        for (int blk = 0; blk < 8; ++blk) {
#pragma unroll
            for (int s = 0; s < 4; ++s) { const bf16x8 Af = __builtin_bit_cast(bf16x8, a_all[blk][s]);
#pragma unroll
                for (int nt = 0; nt < 4; ++nt) { const bf16x8 Bf = *(const LAS bf16x8*)(wr + (nt * 16 + c16) * WR_PITCH + (blk * 128 + s * 32 + rg * 8) * 2);
                    acc[nt] = __builtin_amdgcn_mfma_f32_16x16x32_bf16(Af, Bf, acc[nt], 0, 0, 0); } }
        }
        LDS_BARRIER();
        int sel_lpos[4][4]; int sel_k[4][4]; float sel_w[4][4]; float sel_rs[4];
#pragma unroll
        for (int r = 0; r < 4; ++r) {
            const int tok = t0 + 4 * rg + r;
            float part = SSP[(size_t)tok * 16 + c16]; part = red16_sum(part);
            const float rs = 1.0f / sqrtf(part * (1.f / D) + EPS);
            if (c16 == 0) RSTD2[tok] = rs;
            sel_rs[r] = rs;
            float sc[4], bv[4];
#pragma unroll
            for (int nt = 0; nt < 4; ++nt) { const float lg = acc[nt][r] * rs; sc[nt] = 1.0f / (1.0f + __expf(-lg)); bv[nt] = sc[nt] + bias[nt]; }
            float gs[4];
#pragma unroll
            for (int nt = 0; nt < 4; ++nt) { const float m1 = red8_max(bv[nt]); const int i1 = red8_min(bv[nt] == m1 ? (c16 & 7) : 99); const float v2 = ((c16 & 7) == i1) ? -INFINITY : bv[nt]; gs[nt] = m1 + red8_max(v2); }
            float G8[8];
#pragma unroll
            for (int nt = 0; nt < 4; ++nt) { const float og = dpp_f<0x140>(gs[nt]);     G8[2 * nt] = (c16 < 8) ? gs[nt] : og; G8[2 * nt + 1] = (c16 < 8) ? og : gs[nt]; }
            bool gsel[8];
#pragma unroll
            for (int j = 0; j < 8; ++j) { int rank = 0;
#pragma unroll
                for (int i = 0; i < 8; ++i) if (i != j) rank += (G8[i] > G8[j] || (G8[i] == G8[j] && i < j)) ? 1 : 0;
                gsel[j] = rank < 4; }
            float mv[4];
#pragma unroll
            for (int nt = 0; nt < 4; ++nt) { const bool s_ = (c16 < 8) ? gsel[2 * nt] : gsel[2 * nt + 1]; mv[nt] = s_ ? bv[nt] : -INFINITY; }
            bool picked[4] = {false, false, false, false}; int pk_k[4] = {0, 0, 0, 0}; float wsum = 0.f;
#pragma unroll
            for (int k = 0; k < 8; ++k) {
                float lm = fmaxf(fmaxf(mv[0], mv[1]), fmaxf(mv[2], mv[3])); const float gm = red16_max(lm);
                int li = 999;
#pragma unroll
                for (int nt = 3; nt >= 0; --nt) if (mv[nt] == gm) li = nt * 16 + c16;
                const int gi = red16_min(li);
#pragma unroll
                for (int nt = 0; nt < 4; ++nt) if (gi == nt * 16 + c16) { picked[nt] = true; pk_k[nt] = k; mv[nt] = -INFINITY; wsum += sc[nt]; }
            }
            wsum = red16_sum(wsum);
            const float wn = 2.5f / wsum;
#pragma unroll
            for (int nt = 0; nt < 4; ++nt) { sel_lpos[r][nt] = -1; sel_k[r][nt] = pk_k[nt]; sel_w[r][nt] = sc[nt] * wn;
                if (picked[nt]) sel_lpos[r][nt] = __hip_atomic_fetch_add(&lcnt[nt * 16 + c16], 1, __ATOMIC_RELAXED, __HIP_MEMORY_SCOPE_WORKGROUP); }
        }
        LDS_BARRIER();
        if (tid < 64) gbase[tid] = (int)atomicAdd(&GCNT[tid], (unsigned)lcnt[tid]);
        LDS_BARRIER();
        LAS int* ent = (LAS int*)(F.lds + 64 * WR_PITCH + 1024);
#pragma unroll
        for (int r = 0; r < 4; ++r) { const int tl = wave * 16 + 4 * rg + r, tok = item * 128 + tl;
#pragma unroll
            for (int nt = 0; nt < 4; ++nt) if (sel_lpos[r][nt] >= 0) { const int e = nt * 16 + c16, k = sel_k[r][nt], slot = tok * 8 + k, ix = (tl * 8 + k) * 3;
                ent[ix] = e * 32768 + gbase[e] + sel_lpos[r][nt]; ent[ix + 1] = (int)(((unsigned)slot << 14) | (unsigned)(sel_w[r][nt] * (16383.0f / 2.5f) + 0.5f)); ent[ix + 2] = __builtin_bit_cast(int, sel_rs[r]); } }
        LDS_BARRIER();
#pragma unroll
        for (int i = 0; i < 2; ++i) { const int ei = tid + 512 * i, pos = ent[ei * 3], pl = pos & 32767, rr = pl & 127, tok = item * 128 + (ei >> 3);
            LIST[pos] = ent[ei * 3 + 1]; RSL[pos] = __builtin_bit_cast(float, ent[ei * 3 + 2]);
            TOKP[(pos & ~32767) + (pl & ~127) + (rr & 63) * 2 + (rr >> 6)] = (unsigned short)tok; }
        LDS_BARRIER();
    }
}

__device__ __forceinline__ void build_bst(Frame& F, volatile LAS int* bst) {
    if (F.wave == 0) { const unsigned* cnt = F.ctl + CW_CNT; const int lane = lane_id(); const int nb = ((int)cnt[lane] + 255) >> 8; int s = nb;
#pragma unroll
        for (int o = 1; o < 64; o <<= 1) { const int t = __shfl_up(s, o); if (lane >= o) s += t; }
        bst[lane] = s - nb; bst[66 + lane] = (int)cnt[lane]; if (lane == 63) { bst[64] = s; bst[65] = s + T / 256; bst[66 + 64] = T; } }
    __syncthreads();
}

using pg8::v8i32; using pg8::v8u32;
__host__ __device__ __forceinline__ int dn_perm(int rho) { const int nt = rho >> 4, q = (rho >> 2) & 3, j = rho & 3; return ((nt >> 2) << 6) + 16 * q + 4 * (nt & 3) + j; }
__device__ __forceinline__ void down_phase(Frame& F, const volatile LAS int* bst) {
    const int lane = lane_id(), w = F.wave, fr = lane & 15, fq = lane >> 4, tid = w * 64 + lane;
    LAS unsigned char* L = F.lds;
    const unsigned char* Wd = WSP(const unsigned char, WS_WD); const unsigned char* HA = (const unsigned char*)F.out;
    const unsigned* LISTP = WSP(const unsigned, WS_LIST);
    unsigned char* CT = WSP(unsigned char, WS_CONTRIB); unsigned char* C9 = WSP(unsigned char, WS_CONTRIB9); unsigned char* TR = WSP(unsigned char, WS_TRASH);
    const int NBt = bst[65], Q = (NBt + 7) >> 3, x = F.c & 7, jj = F.c >> 3, per = F.G >> 3;
    int hiL = (x + 1) * Q; hiL = hiL < NBt ? hiL : NBt;
#define DN_UNIT(i_) ((((i_) * per + jj) < Q && (x * Q + (i_) * per + jj) < hiL) ? (x * Q + (i_) * per + jj) : -1)
    unsigned voff[4];
#pragma unroll
    for (int i = 0; i < 4; ++i) { const int s_ = i * 512 + tid, rho = s_ >> 4, p = s_ & 15; voff[i] = (unsigned)(dn_perm(rho) * 256 + ((p ^ (rho & 15)) << 4)); }
#define DN_STAGE(slot_, e_, c_) do { const unsigned char* gb_ = Wd + ((size_t)(e_) * 1024 + 128 * (c_)) * 256; _Pragma("unroll") for (int i_ = 0; i_ < 4; ++i_) \
        __builtin_amdgcn_global_load_lds((const unsigned*)(gb_ + voff[i_]), (LAS unsigned*)(L + (slot_) * 32768 + i_ * 8192 + w * 1024), 16, 0, 0); } while (0)
#define DN_WAIT4() asm volatile("s_waitcnt vmcnt(4)" ::: "memory")
#define DN_BAR() do { asm volatile("s_waitcnt lgkmcnt(0)" ::: "memory"); __builtin_amdgcn_s_barrier(); asm volatile("" ::: "memory"); } while (0)
    const int boffs0 = fr * 256 + (((2 * fq) ^ fr) << 4), boffs1 = fr * 256 + (((2 * fq + 1) ^ fr) << 4), boffs2 = fr * 256 + (((8 + 2 * fq) ^ fr) << 4), boffs3 = fr * 256 + (((8 + 2 * fq + 1) ^ fr) << 4);
#define DN_LDB(D0, D1, sb_, nt_) do { D0 = __builtin_bit_cast(v8i32, (v8u32)__builtin_shufflevector(*(const LAS v4u*)((sb_) + (nt_) * 4096 + boffs0), *(const LAS v4u*)((sb_) + (nt_) * 4096 + boffs1), 0, 1, 2, 3, 4, 5, 6, 7)); \
        D1 = __builtin_bit_cast(v8i32, (v8u32)__builtin_shufflevector(*(const LAS v4u*)((sb_) + (nt_) * 4096 + boffs2), *(const LAS v4u*)((sb_) + (nt_) * 4096 + boffs3), 0, 1, 2, 3, 4, 5, 6, 7)); } while (0)
#define DN_COMPUTE(ACC, slot_) do { const LAS unsigned char* sb_ = L + (slot_) * 32768; v8i32 bc0_, bc1_, bn0_, bn1_; DN_LDB(bc0_, bc1_, sb_, 0); \
        _Pragma("unroll") for (int nt = 0; nt < 8; ++nt) { \
            if (nt < 7) DN_LDB(bn0_, bn1_, sb_, nt + 1); \
            _Pragma("unroll") for (int mt = 0; mt < 2; ++mt) { \
                ACC[mt][nt] = __builtin_amdgcn_mfma_scale_f32_16x16x128_f8f6f4(bc0_, Af[mt][0], (f32x4){0.f, 0.f, 0.f, 0.f}, 0, 0, 0, 0x79797979, 0, 0x7C7C7C7C); \
                ACC[mt][nt] = __builtin_amdgcn_mfma_scale_f32_16x16x128_f8f6f4(bc1_, Af[mt][1], ACC[mt][nt], 0, 0, 0, 0x79797979, 0, 0x7C7C7C7C); } \
            __builtin_amdgcn_sched_barrier(0); bc0_ = bn0_; bc1_ = bn1_; } \
        _Pragma("unroll") for (int nt = 0; nt < 8; ++nt) { asm volatile("" : "+v"(ACC[0][nt]), "+v"(ACC[1][nt])); } } while (0)
#define DN_EPI(ACC, pc_) do { _Pragma("unroll") for (int mt = 0; mt < 2; ++mt) { const int r_ = 32 * w + 16 * mt + fr; const unsigned wd_ = pe_sgp[mt]; const bool routed_ = pe_e < 64; \
        const float gs_ = routed_ ? (float)(wd_ & 16383u) * (2.5f * CSCALE / 16383.0f) : CSCALE; \
        unsigned char* cp_ = routed_ ? CT + (size_t)(wd_ >> 14) * 1024 : C9 + (size_t)(pe_rb * 256 + r_) * 1024; cp_ = (r_ < pe_nv) ? cp_ : TR; cp_ += (pc_) * 128 + 16 * fq; \
        _Pragma("unroll") for (int hh = 0; hh < 2; ++hh) { unsigned wq_[4]; \
            _Pragma("unroll") for (int q = 0; q < 4; ++q) { const f32x4 v_ = ACC[mt][4 * hh + q] * gs_; int p_ = __builtin_amdgcn_cvt_pk_fp8_f32(v_[0], v_[1], 0, false); p_ = __builtin_amdgcn_cvt_pk_fp8_f32(v_[2], v_[3], p_, true); wq_[q] = (unsigned)p_; } \
            *(v4u*)(cp_ + 64 * hh) = (v4u){wq_[0], wq_[1], wq_[2], wq_[3]}; } } } while (0)
#define DN_LOADA(DST, SG, blk_, e_, rb_) do { _Pragma("unroll") for (int mt = 0; mt < 2; ++mt) { const int r_ = 32 * w + 16 * mt + fr; const unsigned char* ap_ = HA + ((size_t)(blk_) * 256 + r_) * 256 + 32 * fq; \
        _Pragma("unroll") for (int ks = 0; ks < 2; ++ks) DST[mt][ks] = __builtin_bit_cast(v8i32, (v8u32)__builtin_shufflevector(__builtin_nontemporal_load((const v4u*)(ap_ + ks * 128)), __builtin_nontemporal_load((const v4u*)(ap_ + ks * 128 + 16)), 0, 1, 2, 3, 4, 5, 6, 7)); \
        SG[mt] = LISTP[(size_t)((e_) < 64 ? (e_) : 0) * 32768 + (rb_) * 256 + r_]; } } while (0)
    int blk = DN_UNIT(0);
    if (blk < 0) return;
    int e = find_expert(bst, blk), rb = blk - bst[e], nv = bst[66 + e] - rb * 256; nv = nv > 256 ? 256 : nv;
    v8i32 Af[2][2]; unsigned sgp[2];
    f32x4 accA[2][8], accB[2][8];
    int pe_e = 0, pe_rb = 0, pe_nv = 0; unsigned pe_sgp[2] = {0u, 0u}; bool pend = false;
    DN_STAGE(0, e, 0); DN_STAGE(1, e, 1);
    DN_LOADA(Af, sgp, blk, e, rb);
    int g = 0;
    for (int ui = 0;; ++ui) {
        const int blk_n = DN_UNIT(ui + 1); const bool has_next = blk_n >= 0;
        int e_n = e, rb_n = rb, nv_n = nv;
        if (has_next) { e_n = find_expert(bst, blk_n); rb_n = blk_n - bst[e_n]; nv_n = bst[66 + e_n] - rb_n * 256; nv_n = nv_n > 256 ? 256 : nv_n; }
#pragma unroll
        for (int c = 0; c < 8; ++c) {
            if (c == 0) asm volatile("s_waitcnt vmcnt(14)" ::: "memory"); else DN_WAIT4();
            DN_BAR();
            if (c == 0) { if (pend) DN_EPI(accB, 7);
                pe_e = e; pe_rb = rb; pe_nv = nv; pe_sgp[0] = sgp[0]; pe_sgp[1] = sgp[1]; }
            else if (c & 1) DN_EPI(accA, c - 1); else DN_EPI(accB, c - 1);
            asm volatile("" ::: "memory");
            if (c != 0) { const int s2 = (g + 2) % 3; if (c < 6) DN_STAGE(s2, e, c + 2); else DN_STAGE(s2, e_n, c - 6); }
            asm volatile("" ::: "memory");
            { const int s0 = g % 3; if (c & 1) DN_COMPUTE(accB, s0); else DN_COMPUTE(accA, s0); }
            if (c == 0) { asm volatile("" ::: "memory"); DN_STAGE((g + 2) % 3, e, 2); asm volatile("" ::: "memory"); }
            ++g;
        }
        pend = true;
        if (!has_next) break;
        blk = blk_n; e = e_n; rb = rb_n; nv = nv_n;
        DN_LOADA(Af, sgp, blk, e, rb);
    }
    DN_EPI(accB, 7);
    asm volatile("s_waitcnt vmcnt(0)" ::: "memory");
#undef DN_UNIT
#undef DN_STAGE
#undef DN_WAIT4
#undef DN_BAR
#undef DN_COMPUTE
#undef DN_LDB
#undef DN_EPI
#undef DN_LOADA
}

__device__ __forceinline__ void combine_phase(Frame& F) {
    const int gw = F.c * NWAVES + F.wave, NGW = F.G * NWAVES, lane = lane_id();
    const bf16* HB = WSP(const bf16, WS_HB); const unsigned char* CT = WSP(const unsigned char, WS_CONTRIB); const unsigned char* C9 = WSP(const unsigned char, WS_CONTRIB9);
    f32x4 gg[4];
    { const f32x4* gp = (const f32x4*)(karg_in(19) + lane * 16);
#pragma unroll
      for (int q = 0; q < 4; ++q) gg[q] = gp[q]; }
    v4u nh0, nh1, nc[9];
#define P9_LOAD(tt) do { nh0 = __builtin_nontemporal_load((const v4u*)(HB + (size_t)(tt) * D + lane * 16)); nh1 = __builtin_nontemporal_load((const v4u*)(HB + (size_t)(tt) * D + lane * 16 + 8)); \
        _Pragma("unroll") for (int k = 0; k < 9; ++k) nc[k] = __builtin_nontemporal_load((const v4u*)((k < 8 ? CT + ((size_t)(tt) * 8 + k) * 1024 : C9 + (size_t)(tt) * 1024) + lane * 16)); } while (0)
    int t = gw;
    if (t < T) P9_LOAD(t);
    for (; t < T; t += NGW) {
        const v4u h0 = nh0, h1 = nh1; v4u cw[9];
#pragma unroll
        for (int k = 0; k < 9; ++k) cw[k] = nc[k];
        if (t + NGW < T) P9_LOAD(t + NGW);
        float v[16];
        v[0] = bflo(h0.x); v[1] = bfhi(h0.x); v[2] = bflo(h0.y); v[3] = bfhi(h0.y); v[4] = bflo(h0.z); v[5] = bfhi(h0.z); v[6] = bflo(h0.w); v[7] = bfhi(h0.w);
        v[8] = bflo(h1.x); v[9] = bfhi(h1.x); v[10] = bflo(h1.y); v[11] = bfhi(h1.y); v[12] = bflo(h1.z); v[13] = bfhi(h1.z); v[14] = bflo(h1.w); v[15] = bfhi(h1.w);
#pragma unroll
        for (int k = 0; k < 9; ++k) { const unsigned w4[4] = {cw[k].x, cw[k].y, cw[k].z, cw[k].w};
#pragma unroll
            for (int q = 0; q < 4; ++q) { const f32x2 lo = __builtin_amdgcn_cvt_pk_f32_fp8((int)w4[q], false), hi = __builtin_amdgcn_cvt_pk_f32_fp8((int)w4[q], true);
                v[4 * q + 0] += lo.x * CINV; v[4 * q + 1] += lo.y * CINV; v[4 * q + 2] += hi.x * CINV; v[4 * q + 3] += hi.y * CINV; } }
        float ss = 0.f;
#pragma unroll
        for (int j = 0; j < 16; ++j) ss += v[j] * v[j];
        const float rstd = 1.0f / sqrtf(wave_sum(ss) * (1.f / D) + EPS);
        f32x4* op = (f32x4*)(F.out + (size_t)t * D + lane * 16);
#pragma unroll
        for (int q = 0; q < 4; ++q) { const f32x4 g = gg[q]; op[q] = (f32x4){v[4 * q] * rstd * g.x, v[4 * q + 1] * rstd * g.y, v[4 * q + 2] * rstd * g.z, v[4 * q + 3] * rstd * g.w}; }
    }
#undef P9_LOAD
}

constexpr int N_PHASES = 10;
__global__ void __launch_bounds__(NWAVES * 64, 2) fwd(Args args) {
    extern __shared__ __attribute__((aligned(16))) unsigned char lds[];
    Frame F;
    F.lds = (LAS unsigned char*)lds; F.MISC = (volatile LAS unsigned*)(F.lds + MISC_OFF);
    F.wave = __builtin_amdgcn_readfirstlane((int)threadIdx.x >> 6);
    F.G = gridDim.x; F.c = blockIdx.x; F.variant = args.variant; F.ws = args.ws; F.out = args.out; F.ctl = (unsigned*)(args.ws + WS_CTL);
    for (int u = (F.wave * 64 + lane_id()); u < 256; u += NWAVES * 64) ((LAS unsigned*)(F.lds + MISC_OFF))[u] = 0u;
    __syncthreads();
    XcdBarrier bar; bar.bar = F.ctl + CW_BAR + args.li * XCD_BAR_WORDS; bar.x = 0; bar.st = nullptr; bar.wave = 0;
    const int lo = args.ph_lo, hi = args.ph_hi;
    if (hi - lo > 1) bar = xcd_barrier_post(F.ctl + CW_BAR + args.li * XCD_BAR_WORDS, F.MISC + 8, F.wave);
#ifndef PH_MASK
#define PH_MASK 0x3ff
#endif
#define IN(k) (((PH_MASK >> (k)) & 1) && lo <= (k) && (k) < hi)
#define SEAM(k) do { if (IN(k) && IN((k) + 1)) xcd_barrier(bar); } while (0)
    volatile LAS int* bst = (volatile LAS int*)(F.MISC + 64);

    if (IN(0)) { p0_prologue(F); } SEAM(0);
    if (IN(1)) {
        StaticOrder S; S.init(WSP(bf16, WS_XN), WSP(bf16, WS_WIN), T, DIN, D, D, D, F.G, F.c);
        EpiZ E{WSP(bf16, WS_Z), WSP(const float, WS_RSTD1), WSP(bf16, WS_CF)};
        pg8::gemm_phase<EpiZ, StaticOrder, true, false>(F.lds, S, E, F.wave);
    } SEAM(1);
    if (IN(2)) { for (int it = F.c; it < T / 128; it += F.G) sgu_item(F, it); }
    if (IN(3)) { f2_phase(F); } SEAM(3);
    if (IN(4)) { for (int it = F.c; it < T / 64; it += F.G) f3_item(F, it); } SEAM(4);
    if (IN(5)) {
        StaticOrder S; S.init(WSP(bf16, WS_MIX), WSP(bf16, WS_WOUT), T, D, D, D, D, F.G, F.c);
        EpiH E{WSP(const bf16, WS_XN), WSP(bf16, WS_HB), WSP(float, WS_SSP), WSP(unsigned char, WS_HB8)};
        pg8::gemm_phase<EpiH, StaticOrder, true, false>(F.lds, S, E, F.wave);
    } SEAM(5);
#if DBG_STOP >= 6
    if (IN(6)) { route_phase(F); } SEAM(6);
#endif
#if DBG_STOP >= 7
    if (IN(7)) {
        build_bst(F, bst);
        SchedGU S; S.hb = (const char*)WSP(unsigned char, WS_HB8); S.Wgu = (const char*)WSP(unsigned char, WS_WGU); S.tokp = WSP(const unsigned short, WS_TOKP); S.cnt = F.ctl + CW_CNT; S.bst = bst;
        S.K = 512; S.lda = 512; S.ldb = 512; S.G = F.G; S.c = F.c; S.NU = 2 * bst[65]; S.Q = (S.NU + 7) / 8;
        EpiGU E{WSP(const float, WS_RSL), WSP(const float, WS_RSTD2), (unsigned char*)F.out, bst};
        pg8::gemm_phase<EpiGU, SchedGU, true, true, true>(F.lds, S, E, F.wave);
    } SEAM(7);
#endif
#if DBG_STOP >= 8
    if (IN(8)) {
        build_bst(F, bst);
        down_phase(F, bst);
    } SEAM(8);
#endif
    if (IN(9)) { combine_phase(F); }
#undef IN
#undef SEAM
}

extern "C" void kernel_launch(void* const* d_in, const int* in_sizes, int n_in, void* d_out, int out_size, void* d_ws, size_t ws_size, hipStream_t stream) {
    static int grid = 0;
    if (grid == 0) {
        if (n_in != 20 || in_sizes[0] != T * D || out_size != T * D || ws_size < WS_END) { fprintf(stderr, "kernel_launch: unexpected shapes / workspace (n_in %d, in0 %d, out %d, ws %zu)\n", n_in, n_in > 0 ? in_sizes[0] : -1, out_size, ws_size); grid = -1; return; }
        int dev = 0, cus = 0, per_cu = 0;
        if (hipGetDevice(&dev) != hipSuccess || hipDeviceGetAttribute(&cus, hipDeviceAttributeMultiprocessorCount, dev) != hipSuccess) { grid = -1; return; }
        if (hipFuncSetAttribute((const void*)fwd, hipFuncAttributeMaxDynamicSharedMemorySize, LDS_BYTES) != hipSuccess) { fprintf(stderr, "kernel_launch: hipFuncSetAttribute failed\n"); grid = -1; return; }
        if (hipOccupancyMaxActiveBlocksPerMultiprocessor(&per_cu, (const void*)fwd, NWAVES * 64, LDS_BYTES) != hipSuccess || per_cu < 1) fprintf(stderr, "kernel_launch: occupancy query reports %d\n", per_cu);
        (void)hipGetLastError();
        grid = cus;
        if (grid % 8 != 0 || grid > 1024) { fprintf(stderr, "kernel_launch: unexpected CU count %d\n", cus); }
    }
    if (grid < 0) return;
    if (hipMemsetAsync((char*)d_ws + WS_CTL, 0, CTL_ZERO_BYTES, stream) != hipSuccess) return;
    Args a{};
    for (int i = 0; i < 20; ++i) a.in[i] = (const float*)d_in[i];
    a.out = (float*)d_out; a.ws = (unsigned char*)d_ws;
    const int nl = MK_N_LAUNCHES;
    for (int li = 0; li < nl; ++li) {
        a.ph_lo = (nl == N_PHASES) ? li : (li * N_PHASES) / nl; a.ph_hi = (nl == N_PHASES) ? li + 1 : ((li + 1) * N_PHASES) / nl; a.li = li;
#if defined(REP_MASK)
        if (nl == N_PHASES && ((REP_MASK >> li) & 1)) for (int rep = 0; rep < REP_N; ++rep) { a.variant = REP_VARIANT; hipLaunchKernelGGL(fwd, dim3(grid), dim3(NWAVES * 64), LDS_BYTES, stream, a); a.variant = 0;
            if (li == 6) (void)hipMemsetAsync((char*)d_ws + WS_CTL + CW_CNT * 4, 0, 256, stream); }
#endif
        hipLaunchKernelGGL(fwd, dim3(grid), dim3(NWAVES * 64), LDS_BYTES, stream, a);
        if (hipPeekAtLastError() != hipSuccess) { fprintf(stderr, "kernel_launch: launch %d failed\n", li); break; }

    }
}
```

```cpp
#include <hip/hip_runtime.h>
#include <cstdio>
#include <cstdint>

#ifndef MK_N_LAUNCHES
#define MK_N_LAUNCHES 1
#endif
#ifndef DBG_STOP
#define DBG_STOP 99
#endif

#define GAS __attribute__((address_space(1)))
#define LAS __attribute__((address_space(3)))
typedef unsigned short bf16;
typedef unsigned v4u __attribute__((ext_vector_type(4)));
typedef unsigned v2u __attribute__((ext_vector_type(2)));
typedef float f32x4 __attribute__((ext_vector_type(4)));
typedef float f32x2 __attribute__((ext_vector_type(2)));
typedef short bf16x8 __attribute__((ext_vector_type(8)));

constexpr int T = 32768, D = 1024, DIN = 1536, DA = 512, NE = 64, DE = 256, SEQ = 4096, NB_ = 8;
constexpr float EPS = 1e-6f;
constexpr int NCOLF = 8 * 8 * 33;
constexpr float CSCALE = 16.0f, CINV = 1.0f / 16.0f;

constexpr size_t MiB = 1u << 20;
constexpr size_t WS_CTL = 0, CTL_ZERO_BYTES = 65536;
constexpr size_t WS_WIN = 1 * MiB;
constexpr size_t WS_WOUT = 4 * MiB;
constexpr size_t WS_WR = 6 * MiB;
constexpr size_t WS_WSB = 6 * MiB + 256 * 1024;
constexpr size_t WS_TW = 6 * MiB + 512 * 1024;
constexpr size_t WS_RSTD2 = 6 * MiB + 768 * 1024;
constexpr int FB_OFF = 0, GT_OFF = 34816, TWL_OFF = 52224, XI_OFF = 68608, XI_SZ = 18432, TI_OFF = 105472, FPITCH = 272, XPITCH = 144;
constexpr size_t WS_F2IMG = 7 * MiB;
constexpr size_t WS_RSTD1 = 6 * MiB + 896 * 1024;
constexpr size_t WS_SSP = 8 * MiB;
constexpr size_t WS_LIST = 10 * MiB;
constexpr size_t WS_RSL = 18 * MiB;
constexpr size_t WS_GL = 26 * MiB;
constexpr size_t WS_TOKP = 34 * MiB;
constexpr size_t WS_WGU = 38 * MiB;
constexpr size_t WS_WD = 71 * MiB;
constexpr size_t WS_HB = 88 * MiB;
constexpr size_t WS_HB8 = 152 * MiB;
constexpr size_t WS_CONTRIB = 184 * MiB;
constexpr size_t WS_XN = 184 * MiB;
constexpr size_t WS_MIX = 411 * MiB;
constexpr size_t WS_Z = 248 * MiB;
constexpr size_t WS_CF = 344 * MiB;
constexpr size_t WS_YT = 378 * MiB;
constexpr size_t WS_CONTRIB9 = 440 * MiB;
constexpr size_t WS_TRASH = 6 * MiB + 512 * 1024 + 65536;
constexpr size_t WS_END = 512 * MiB;
constexpr float WSCALE = 64.0f, HSCALE = 8.0f;
__device__ __forceinline__ float sat8(float x) { return __builtin_amdgcn_fmed3f(x, -440.0f, 440.0f); }
constexpr int CW_BAR = 4096;
constexpr int CW_CNT = 8192;

constexpr int RING_BYTES = 131072;
constexpr int LDS_BYTES = 155648;
constexpr int MISC_OFF = LDS_BYTES - 1024;
constexpr int NWAVES = 8;

#define LDS_WAIT() asm volatile("s_waitcnt lgkmcnt(0)" ::: "memory")
#define VM_WAIT() asm volatile("s_waitcnt vmcnt(0)" ::: "memory")
#define LDS_BARRIER() do { asm volatile("s_waitcnt lgkmcnt(0)" ::: "memory"); __builtin_amdgcn_s_barrier(); asm volatile("" ::: "memory"); } while (0)
__device__ __forceinline__ unsigned f2bf(float f) { unsigned u = __builtin_bit_cast(unsigned, f); return (u + 0x7fffu + ((u >> 16) & 1u)) >> 16; }
__device__ __forceinline__ unsigned pk2(float lo, float hi) { return f2bf(lo) | (f2bf(hi) << 16); }
__device__ __forceinline__ float bflo(unsigned w) { return __builtin_bit_cast(float, w << 16); }
__device__ __forceinline__ float bfhi(unsigned w) { return __builtin_bit_cast(float, w & 0xffff0000u); }
__device__ __forceinline__ int lane_id() { int r; asm volatile("v_mbcnt_lo_u32_b32 %0, -1, 0\n\tv_mbcnt_hi_u32_b32 %0, -1, %0" : "=v"(r)); return r; }
template <int CTRL> __device__ __forceinline__ float dpp_f(float v) { return __builtin_bit_cast(float, __builtin_amdgcn_update_dpp(0, __builtin_bit_cast(int, v), CTRL, 0xF, 0xF, false)); }
template <int CTRL> __device__ __forceinline__ int dpp_i(int v) { return __builtin_amdgcn_update_dpp(0, v, CTRL, 0xF, 0xF, false); }
__device__ __forceinline__ float xor16_sum(float v) { const auto s = __builtin_amdgcn_permlane16_swap(__builtin_bit_cast(unsigned, v), __builtin_bit_cast(unsigned, v), false, false); return __builtin_bit_cast(float, (unsigned)s[0]) + __builtin_bit_cast(float, (unsigned)s[1]); }
__device__ __forceinline__ float xor32_sum(float v) { const auto s = __builtin_amdgcn_permlane32_swap(__builtin_bit_cast(unsigned, v), __builtin_bit_cast(unsigned, v), false, false); return __builtin_bit_cast(float, (unsigned)s[0]) + __builtin_bit_cast(float, (unsigned)s[1]); }
__device__ __forceinline__ float row16_sum(float v) { v += dpp_f<0xB1>(v); v += dpp_f<0x4E>(v); v += dpp_f<0x141>(v); v += dpp_f<0x140>(v); return v; }
__device__ __forceinline__ float wave_sum(float v) { return xor32_sum(xor16_sum(row16_sum(v))); }

namespace pg8 {
constexpr int BM = 256, BK = 64, HALF = 128, HTB = HALF * BK * 2, STAGE_BYTES = 8 * HTB;
__host__ __device__ __forceinline__ int lds_byte(int r, int c) { const int st = (r >> 4) * 2 + (c >> 5), rr = r & 15, cc = c & 31, ob = rr * 64 + cc * 2; return st * 1024 + (ob ^ (((ob >> 9) & 1) << 5)); }
__host__ __device__ __forceinline__ void stage_rc(int b, int& R, int& C) { const int st = b / 1024, sb = b % 1024, swz = sb ^ (((sb >> 9) & 1) << 5); R = (st >> 1) * 16 + swz / 64; C = (st & 1) * 32 + (swz % 64) / 2; }
__host__ __device__ __forceinline__ int perm32(int rho) { const int n = rho >> 4, i = rho & 15; return 8 * (i >> 2) + 4 * n + (i & 3); }
__host__ __device__ __forceinline__ int perm32b(int rho) { const int n = rho >> 4, i = rho & 15, q = i >> 2; return 16 * (q & 1) + 8 * (q >> 1) + 4 * n + (i & 3); }

struct Unit { const char* A; const char* B; int pm, pn, e, nvalid; };

__device__ __forceinline__ unsigned cvt_pk_bf16(float lo, float hi) { unsigned r; asm volatile("v_cvt_pk_bf16_f32 %0, %1, %2" : "=v"(r) : "v"(lo), "v"(hi)); return r; }
__device__ __forceinline__ f32x2 gelu_pk(f32x2 v) {
    const f32x2 av = __builtin_elementwise_abs(v), d = av * 0.2316418882f + 1.0f;
    f32x2 t; t.x = __builtin_amdgcn_rcpf(d.x); t.y = __builtin_amdgcn_rcpf(d.y);
    f32x2 q = t * 0.5307027145f + (-0.7265760135f); q = q * t + 0.7107068705f; q = q * t + (-0.142248368f); q = q * t + 0.127414796f; q = q * t;
    const f32x2 s = (v * v) * (-0.72134752044f);
    f32x2 e; e.x = __builtin_amdgcn_exp2f(s.x); e.y = __builtin_amdgcn_exp2f(s.y);
    const f32x2 m = v * (q * e), r = v - m;
    f32x2 o; o.x = v.x < 0.f ? m.x : r.x; o.y = v.y < 0.f ? m.y : r.y; return o;
}

typedef int v8i32 __attribute__((ext_vector_type(8)));
typedef unsigned v8u32 __attribute__((ext_vector_type(8)));
template <class Epi, class Sched, bool ALIGN_EPI, bool GATHER, bool FP8 = false>
__device__ __forceinline__ void gemm_phase(LAS unsigned char* lds, const Sched& S, const Epi& E, int wid) {
    const int lane = lane_id(), tid = wid * 64 + lane, wr = wid >> 2, wc = wid & 3, fr = lane & 15, fq = lane >> 4;
    const int K = S.K, nt = K / BK, lda = S.lda, ldb = S.ldb;
    unsigned voffA[2], voffB[2]; int RA[2];
#pragma unroll
    for (int i = 0; i < 2; ++i) { int R, C; stage_rc(tid * 16 + i * 8192, R, C); const int Rb = Epi::PERM == 2 ? ((R & ~31) + perm32b(R & 31)) : (Epi::PERM ? ((R & ~31) + perm32(R & 31)) : R);
        const int Ra = Epi::PERM_A ? ((R & ~31) + perm32(R & 31)) : R;
        voffA[i] = GATHER ? (unsigned)(C * 2) : (unsigned)(Ra * lda + C) * 2u; voffB[i] = (unsigned)(Rb * ldb + C) * 2u; RA[i] = R; }
    const size_t kstep = (size_t)(BK * 2);
    const size_t hstepA = (size_t)HALF * lda * 2, hstepB = (size_t)HALF * ldb * 2;
    const unsigned ldsw = (unsigned)wid * 1024u;
    const int aoff = lds_byte(wr * 64 + fr, fq * 8), boff = lds_byte(wc * 32 + fr, fq * 8);
#define PG8_SA(b, h) (((b) * 2 + (h)) * HTB)
#define PG8_SB(b, h) ((4 + (b) * 2 + (h)) * HTB)
#define PG8_GLDS(gp, bufoff, i_) __builtin_amdgcn_global_load_lds((const unsigned*)(gp), (LAS unsigned*)(lds + (bufoff) + ldsw + (i_) * 8192), 16, 0, 0)
#define PG8_STAGE_B(bufoff, gbase) do { PG8_GLDS((const char*)(gbase) + voffB[0], bufoff, 0); PG8_GLDS((const char*)(gbase) + voffB[1], bufoff, 1); } while (0)
#define PG8_STAGE_A(bufoff, gbase, h_, o_) do { if constexpr (GATHER) { PG8_GLDS((const char*)(gbase) + ((o_[h_] & 0x7fffu) * (unsigned)(lda * 2) + voffA[0]), bufoff, 0); PG8_GLDS((const char*)(gbase) + (((o_[h_] >> 16) & 0x7fffu) * (unsigned)(lda * 2) + voffA[1]), bufoff, 1); } \
        else { PG8_GLDS((const char*)(gbase) + (h_) * hstepA + voffA[0], bufoff, 0); PG8_GLDS((const char*)(gbase) + (h_) * hstepA + voffA[1], bufoff, 1); } } while (0)
#define PG8_LD8(p_) __builtin_shufflevector(*(const LAS v4u*)(p_), *(const LAS v4u*)((p_) + 1024), 0, 1, 2, 3, 4, 5, 6, 7)
#define PG8_LDA(dst, b, h) do { _Pragma("unroll") for (int m = 0; m < 4; ++m) dst[m] = PG8_LD8(lds + PG8_SA(b, h) + aoff + m * 2048); } while (0)
#define PG8_LDB(dst, b, h) do { _Pragma("unroll") for (int n = 0; n < 2; ++n) dst[n] = PG8_LD8(lds + PG8_SB(b, h) + boff + n * 2048); } while (0)
#define PG8_MMA(ai, bj, At, Bt) do { __builtin_amdgcn_s_setprio(1); _Pragma("unroll") for (int m = 0; m < 4; ++m) _Pragma("unroll") for (int n = 0; n < 2; ++n) { \
        if constexpr (FP8) { acc[ai][bj][m][n] = __builtin_amdgcn_mfma_scale_f32_16x16x128_f8f6f4(__builtin_bit_cast(v8i32, Bt[n]), __builtin_bit_cast(v8i32, At[m]), acc[ai][bj][m][n], 0, 0, 0, Epi::SCALE_B, 0, Epi::SCALE_A); } \
        else { acc[ai][bj][m][n] = __builtin_amdgcn_mfma_f32_16x16x32_bf16(__builtin_bit_cast(bf16x8, __builtin_shufflevector(Bt[n], Bt[n], 0, 1, 2, 3)), __builtin_bit_cast(bf16x8, __builtin_shufflevector(At[m], At[m], 0, 1, 2, 3)), acc[ai][bj][m][n], 0, 0, 0); \
               acc[ai][bj][m][n] = __builtin_amdgcn_mfma_f32_16x16x32_bf16(__builtin_bit_cast(bf16x8, __builtin_shufflevector(Bt[n], Bt[n], 4, 5, 6, 7)), __builtin_bit_cast(bf16x8, __builtin_shufflevector(At[m], At[m], 4, 5, 6, 7)), acc[ai][bj][m][n], 0, 0, 0); } } \
        if constexpr (FP8) { _Pragma("unroll") for (int m = 0; m < 4; ++m) _Pragma("unroll") for (int n = 0; n < 2; ++n) asm volatile("" : "+v"(acc[ai][bj][m][n])); }     \
        __builtin_amdgcn_s_setprio(0); } while (0)
#define PG8_MMAT(ai, bj, At, Bt) do { __builtin_amdgcn_s_setprio(1); _Pragma("unroll") for (int m = 0; m < 4; ++m) _Pragma("unroll") for (int n = 0; n < 2; ++n) { \
        acc[ai][bj][m][n] = __builtin_amdgcn_mfma_f32_16x16x32_bf16(__builtin_bit_cast(bf16x8, __builtin_shufflevector(At[m], At[m], 0, 1, 2, 3)), __builtin_bit_cast(bf16x8, __builtin_shufflevector(Bt[n], Bt[n], 0, 1, 2, 3)), acc[ai][bj][m][n], 0, 0, 0); \
        acc[ai][bj][m][n] = __builtin_amdgcn_mfma_f32_16x16x32_bf16(__builtin_bit_cast(bf16x8, __builtin_shufflevector(At[m], At[m], 4, 5, 6, 7)), __builtin_bit_cast(bf16x8, __builtin_shufflevector(Bt[n], Bt[n], 4, 5, 6, 7)), acc[ai][bj][m][n], 0, 0, 0); } \
        __builtin_amdgcn_s_setprio(0); } while (0)
#define PG8_WAIT_V(n) asm volatile("s_waitcnt vmcnt(" #n ")" ::: "memory")
#define PG8_WAIT_L(n) asm volatile("s_waitcnt lgkmcnt(" #n ")" ::: "memory")
#define PG8_BAR __builtin_amdgcn_s_barrier()
#define PG8_SCHED __builtin_amdgcn_sched_barrier(0)
#define PG8_KLOOP(MMAX) \
        for (int t = 0; t < nt; t += 2) { \
            const bool last = (t == nt - 2); \
            const char* a1 = cA + (size_t)(t + 1) * kstep; \
            const char* a2 = last ? nA : cA + (size_t)(t + 2) * kstep; const char* b2 = last ? nB : cB + (size_t)(t + 2) * kstep; \
            const char* a3 = a2 + kstep; const char* b3 = b2 + kstep; \
            unsigned o2[2]; \
_Pragma("unroll") \
            for (int h = 0; h < 2; ++h) o2[h] = last ? on[h] : oc[h]; \
            PG8_LDB(B0, 0, 0); PG8_LDB(B1, 0, 1); PG8_SCHED; PG8_LDA(At, 0, 0); PG8_STAGE_A(PG8_SA(1, 1), a1, 1, oc); \
            PG8_WAIT_V(8); PG8_WAIT_L(0); PG8_BAR; MMAX(0, 0, At, B0); MMAX(0, 1, At, B1); PG8_BAR; PG8_SCHED; \
            PG8_LDA(At, 0, 1); PG8_STAGE_B(PG8_SB(0, 0), b2); PG8_STAGE_B(PG8_SB(0, 1), b2 + hstepB); PG8_STAGE_A(PG8_SA(0, 0), a2, 0, o2); \
            PG8_WAIT_V(8); PG8_WAIT_L(0); PG8_BAR; MMAX(1, 0, At, B0); MMAX(1, 1, At, B1); PG8_BAR; PG8_SCHED; \
            PG8_LDB(B0, 1, 0); PG8_LDB(B1, 1, 1); PG8_SCHED; PG8_LDA(At, 1, 0); PG8_STAGE_A(PG8_SA(0, 1), a2, 1, o2); \
            PG8_WAIT_V(8); PG8_WAIT_L(0); PG8_BAR; MMAX(0, 0, At, B0); MMAX(0, 1, At, B1); PG8_BAR; PG8_SCHED; \
            PG8_LDA(At, 1, 1); PG8_STAGE_B(PG8_SB(1, 0), b3); PG8_STAGE_B(PG8_SB(1, 1), b3 + hstepB); PG8_STAGE_A(PG8_SA(1, 0), a3, 0, o2); \
            PG8_WAIT_V(8); PG8_WAIT_L(0); PG8_BAR; MMAX(1, 0, At, B0); MMAX(1, 1, At, B1); PG8_BAR; PG8_SCHED; \
        }
    Unit cur, nxt; int ui = 0;
    if (!S.next(0, cur)) return;
    f32x4 acc[2][2][4][2];
#pragma unroll
    for (int a = 0; a < 2; ++a)
#pragma unroll
        for (int b = 0; b < 2; ++b)
#pragma unroll
            for (int m = 0; m < 4; ++m)
#pragma unroll
                for (int n = 0; n < 2; ++n) acc[a][b][m][n] = (f32x4){0.f, 0.f, 0.f, 0.f};
    v8u32 At[4], B0[2], B1[2];
    unsigned oc[2], on[2];
#pragma unroll
    for (int h = 0; h < 2; ++h) { oc[h] = GATHER ? S.gather2(cur, h, RA[0]) : 0u; on[h] = oc[h]; }
    const char* cA = cur.A; const char* cB = cur.B;
    PG8_STAGE_B(PG8_SB(0, 0), cB); PG8_STAGE_B(PG8_SB(0, 1), cB + hstepB); PG8_STAGE_A(PG8_SA(0, 0), cA, 0, oc); PG8_STAGE_A(PG8_SA(0, 1), cA, 1, oc);
    if (wr == 1) PG8_BAR;
    PG8_WAIT_V(2); PG8_BAR;
    PG8_STAGE_B(PG8_SB(1, 0), cB + kstep); PG8_STAGE_A(PG8_SA(1, 0), cA + kstep, 0, oc); PG8_STAGE_B(PG8_SB(1, 1), cB + hstepB + kstep);
    PG8_WAIT_V(6); PG8_BAR;
    for (;;) {
        const bool has_next = S.next(ui + 1, nxt);
        const char* nA = has_next ? nxt.A : cA; const char* nB = has_next ? nxt.B : cB;
        if constexpr (GATHER) {
            if (has_next) {
#pragma unroll
                for (int h = 0; h < 2; ++h) on[h] = S.gather2(nxt, h, RA[0]);
            }
        }
        unsigned pf[2];
        if constexpr (Epi::PREFETCH) E.prefetch(cur, wr, fr, fq, pf);
        if constexpr (Epi::DUAL) { if (E.transposed(cur)) { PG8_KLOOP(PG8_MMAT) } else { PG8_KLOOP(PG8_MMA) } } else { PG8_KLOOP(PG8_MMA) }
        if constexpr (ALIGN_EPI) { if (wr == 0) PG8_BAR; }
        if constexpr (Epi::DUAL) { if (E.transposed(cur)) E.epiT(acc, cur, wr, wc, fr, fq); else E(acc, cur, wr, wc, fr, fq); }
        else if constexpr (Epi::PREFETCH) E(acc, cur, wr, wc, fr, fq, pf); else E(acc, cur, wr, wc, fr, fq);
        if (!has_next) break;
#pragma unroll
        for (int a = 0; a < 2; ++a)
#pragma unroll
            for (int b = 0; b < 2; ++b)
#pragma unroll
                for (int m = 0; m < 4; ++m)
#pragma unroll
                    for (int n = 0; n < 2; ++n) acc[a][b][m][n] = (f32x4){0.f, 0.f, 0.f, 0.f};
        cur = nxt; cA = nA; cB = nB; ++ui;
        oc[0] = on[0]; oc[1] = on[1];
        if constexpr (ALIGN_EPI) { if (wr == 1) PG8_BAR; }
    }
    PG8_WAIT_V(0);
    if constexpr (!ALIGN_EPI) { if (wr == 0) PG8_BAR; }
    PG8_BAR;
#undef PG8_SA
#undef PG8_SB
#undef PG8_GLDS
#undef PG8_STAGE_A
#undef PG8_STAGE_B
#undef PG8_LDA
#undef PG8_LDB
#undef PG8_MMA
#undef PG8_MMAT
#undef PG8_KLOOP
#undef PG8_WAIT_V
#undef PG8_WAIT_L
#undef PG8_BAR
#undef PG8_SCHED
}
}

#define XB_TMO      128
#define XB_XCNT(j)  (256  + 64 * (j))
#define XB_XSUB(j)  (1280 + 64 * (j))
#define XB_XGEN(j)  (2304 + 64 * (j))
#define XB_TOP      3328
#define XB_TOPGEN   3392
#define XCD_BAR_WORDS 3456
#define XB_SPIN_CAP (1u << 18)
__device__ __forceinline__ unsigned xb_ld(unsigned* p)              { return __hip_atomic_load(p, __ATOMIC_RELAXED, __HIP_MEMORY_SCOPE_AGENT); }
__device__ __forceinline__ unsigned xb_add(unsigned* p, unsigned v) { return __hip_atomic_fetch_add(p, v, __ATOMIC_RELAXED, __HIP_MEMORY_SCOPE_AGENT); }
__device__ __forceinline__ unsigned xb_xcc_id() { return (unsigned)__builtin_amdgcn_s_getreg((3 << 11) | 20) & 0xFu; }
#define XB_SPIN(cond, bar) do { unsigned _sp = 0; while (cond) { __builtin_amdgcn_s_sleep(1); \
    if ((++_sp & 255u) == 0u) { if (xb_ld(&(bar)[XB_TMO])) break; if (_sp > XB_SPIN_CAP) { atomicAdd(&(bar)[XB_TMO], 1u); break; } } } } while (0)
struct XcdBarrier { unsigned* bar; unsigned x; volatile LAS unsigned* st; int wave; };
__device__ __forceinline__ XcdBarrier xcd_barrier_post(unsigned* bar, volatile LAS unsigned* st, int wave) {
    XcdBarrier b; b.bar = bar; b.x = xb_xcc_id(); b.st = st; b.wave = wave;
    if (wave == 0 && lane_id() == 0) (void)xb_add(&bar[XB_XCNT(b.x)], 1u);
    return b;
}
__device__ __forceinline__ void xcd_barrier_complete(unsigned* bar, unsigned x, unsigned& nloc, unsigned& nx) {
    const unsigned G = gridDim.x * gridDim.y * gridDim.z;
    unsigned sum, cnt, mine, sp = 0u;
    for (;;) {
        sum = 0u; cnt = 0u; mine = 0u;
#pragma unroll
        for (unsigned j = 0; j < 16; ++j) { const unsigned c = xb_ld(&bar[XB_XCNT(j)]); sum += c; cnt += (c > 0u) ? 1u : 0u; mine = (j == x) ? c : mine; }
        if (sum == G) break;
        __builtin_amdgcn_s_sleep(1);
        if ((++sp & 255u) == 0u) { if (xb_ld(&bar[XB_TMO])) break; if (sp > XB_SPIN_CAP) { atomicAdd(&bar[XB_TMO], 1u); break; } }
    }
    nloc = mine > 0u ? mine : 1u; nx = cnt > 0u ? cnt : 1u;
}
__device__ __forceinline__ void xcd_barrier(const XcdBarrier& b) {
    asm volatile("s_waitcnt vmcnt(0)" ::: "memory");
    __syncthreads();
    if (b.wave == 0 && lane_id() == 0) {
        unsigned* bar = b.bar;
        __builtin_amdgcn_s_waitcnt(0);
        unsigned nloc = b.st[0], nx = b.st[1];
        if (nloc == 0u) { xcd_barrier_complete(bar, b.x, nloc, nx); b.st[0] = nloc; b.st[1] = nx; }
        const unsigned old = xb_add(&bar[XB_XSUB(b.x)], 1u);
        const unsigned gen = old / nloc;
        if (old + 1u == (gen + 1u) * nloc) {
            __builtin_amdgcn_fence(__ATOMIC_RELEASE, "agent");
            asm volatile("s_waitcnt vmcnt(0)" ::: "memory");
            const unsigned og = xb_add(&bar[XB_TOP], 1u);
            const unsigned tg = og / nx;
            if (og + 1u == (tg + 1u) * nx) xb_add(&bar[XB_TOPGEN], 1u);
            else XB_SPIN(xb_ld(&bar[XB_TOPGEN]) == tg, bar);
            __builtin_amdgcn_fence(__ATOMIC_ACQUIRE, "agent");
            xb_add(&bar[XB_XGEN(b.x)], 1u);
            asm volatile("s_waitcnt vmcnt(0)" ::: "memory");
        } else {
            XB_SPIN(xb_ld(&bar[XB_XGEN(b.x)]) == gen, bar);
            __builtin_amdgcn_fence(__ATOMIC_ACQUIRE, "agent");
            asm volatile("s_waitcnt vmcnt(0)" ::: "memory");
        }
    }
    __syncthreads();
}

struct Args { const float* in[20]; float* out; unsigned char* ws; int ph_lo, ph_hi, li, variant; };
struct Frame {
    LAS unsigned char* lds; volatile LAS unsigned* MISC; unsigned* ctl;
    int wave, G, c, variant;
    unsigned char* ws; float* out;
};
#define WSP(T_, off) ((T_*)(F.ws + (off)))
__device__ __forceinline__ const float* karg_in(int i) { return ((const float* const __attribute__((address_space(4)))*)__builtin_amdgcn_kernarg_segment_ptr())[i]; }

struct StaticOrder {
    const char* A; const char* B; int K, lda, ldb; int nM, nN, nwg, G, c;
    __device__ void init(const void* A_, const void* B_, int M, int N, int K_, int lda_, int ldb_, int G_, int c_) { A = (const char*)A_; B = (const char*)B_; K = K_; lda = lda_; ldb = ldb_; nM = M / 256; nN = N / 256; nwg = nM * nN; G = G_; c = c_; }
    __device__ __forceinline__ bool next(int i, pg8::Unit& u) const {
        const long L = (long)i * G + c; if (L >= nwg) return false;
        int wgid = (int)L; { const int q = nwg / 8, r = nwg % 8, xcd = wgid % 8, off = wgid / 8; wgid = (xcd < r ? xcd * (q + 1) : r * (q + 1) + (xcd - r) * q) + off; }
        const int nig = 8 * nN, gid = wgid / nig, fm = gid * 8, gsz = (nM - fm) < 8 ? (nM - fm) : 8;
        u.pm = fm + ((wgid % nig) % gsz); u.pn = (wgid % nig) / gsz; u.e = 0; u.nvalid = 256;
        u.A = A + (size_t)u.pm * 256 * lda * 2; u.B = B + (size_t)u.pn * 256 * ldb * 2; return true;
    }
    __device__ __forceinline__ unsigned gather2(const pg8::Unit&, int, int) const { return 0u; }
};
__device__ __forceinline__ int find_expert(const volatile LAS int* bst, int blk) { int lo = 0, hi = 65; while (hi - lo > 1) { const int mid = (lo + hi) >> 1; if (bst[mid] <= blk) lo = mid; else hi = mid; } return lo; }
struct SchedGU {
    const char* hb; const char* Wgu; const unsigned short* tokp; const unsigned* cnt; const volatile LAS int* bst;
    int K, lda, ldb, G, c, NU, Q;
    __device__ __forceinline__ bool next(int i, pg8::Unit& u) const {
        const int x = c & 7, j = c >> 3, per = G >> 3; const int L = x * Q + i * per + j; int hiL = (x + 1) * Q; hiL = hiL < NU ? hiL : NU;
        if (i * per + j >= Q || L >= hiL) return false;
        int lo = 0, hi = 65; while (hi - lo > 1) { const int mid = (lo + hi) >> 1; if (2 * bst[mid] <= L) lo = mid; else hi = mid; }
        const int e = lo, loc = L - 2 * bst[e], uu = loc & 1, rb = loc >> 1;
        u.e = e; u.pm = rb; u.pn = uu; u.A = hb; u.B = Wgu + ((size_t)e * 512 + uu * 256) * 1024;
        int nv = bst[66 + e] - rb * 256; nv = nv > 256 ? 256 : nv; u.nvalid = nv; return true;
    }
    __device__ __forceinline__ unsigned gather2(const pg8::Unit& u, int h, int R0) const {
        if (u.e >= 64) { const unsigned t = (unsigned)(u.pm * 256 + h * 128 + R0); return t | ((t + 64u) << 16); }
        return *(const unsigned*)(tokp + (size_t)u.e * 32768 + u.pm * 256 + h * 128 + 2 * R0);
    }
};
struct SchedDN {
    const char* hact_lo; const char* hact_hi; const char* Wd; const unsigned* cnt; const volatile LAS int* bst;
    int K, lda, ldb, G, c, NU, Q;
    __device__ __forceinline__ bool next(int i, pg8::Unit& u) const {
        const int x = c & 7, j = c >> 3, per = G >> 3; const int L = x * Q + i * per + j; int hiL = (x + 1) * Q; hiL = hiL < NU ? hiL : NU;
        if (i * per + j >= Q || L >= hiL) return false;
        const int blk = L >> 2, pn = L & 3; const int e = find_expert(bst, blk), rb = blk - bst[e];
        u.e = e; u.pm = rb; u.pn = pn;
        u.A = hact_lo + (size_t)blk * 65536;
        u.B = Wd + ((size_t)e * 1024 + pn * 256) * 256;
        int nv = bst[66 + e] - rb * 256; nv = nv > 256 ? 256 : nv; u.nvalid = nv; return true;
    }
    __device__ __forceinline__ unsigned gather2(const pg8::Unit&, int, int) const { return 0u; }
};

struct EpiZ {
    static constexpr bool PERM_A = true, DUAL = true;
    static constexpr int PERM = 1; static constexpr bool PREFETCH = false; static constexpr int SCALE_A = 0, SCALE_B = 0;
    bf16* Z; const float* rstd1; bf16* CF;
    __device__ __forceinline__ bool transposed(const pg8::Unit& u) const { return u.pn >= 4; }
    __device__ __forceinline__ void operator()(const f32x4 (&acc)[2][2][4][2], const pg8::Unit& u, int wr, int wc, int fr, int fq) const {
        const int row0 = u.pm * 256 + wr * 64 + 8 * (fr >> 2) + (fr & 3), col0 = u.pn * 256 + wc * 32 + 8 * fq;
        float rsv[8];
#pragma unroll
        for (int q = 0; q < 8; ++q) rsv[q] = rstd1[row0 + (q >> 2) * 128 + ((q >> 1) & 1) * 32 + (q & 1) * 4];
#pragma unroll
        for (int ai = 0; ai < 2; ++ai)
#pragma unroll
            for (int m = 0; m < 4; ++m) { bf16* rowp = Z + (size_t)(row0 + ai * 128 + (m >> 1) * 32 + (m & 1) * 4) * DIN + col0; const float rs = rsv[ai * 4 + m];
#pragma unroll
                for (int bj = 0; bj < 2; ++bj) { f32x4 v0 = acc[ai][bj][m][0] * rs, v1 = acc[ai][bj][m][1] * rs;
                    { f32x2 a = pg8::gelu_pk((f32x2){v0[0], v0[1]}), b = pg8::gelu_pk((f32x2){v0[2], v0[3]}), c = pg8::gelu_pk((f32x2){v1[0], v1[1]}), d = pg8::gelu_pk((f32x2){v1[2], v1[3]});
                        v0 = (f32x4){a.x, a.y, b.x, b.y}; v1 = (f32x4){c.x, c.y, d.x, d.y}; }
                    v4u w; w.x = pg8::cvt_pk_bf16(v0[0], v0[1]); w.y = pg8::cvt_pk_bf16(v0[2], v0[3]); w.z = pg8::cvt_pk_bf16(v1[0], v1[1]); w.w = pg8::cvt_pk_bf16(v1[2], v1[3]);
                    *(v4u*)(rowp + bj * 128) = w; } }
    }
    __device__ __forceinline__ void epiT(const f32x4 (&acc)[2][2][4][2], const pg8::Unit& u, int wr, int wc, int fr, int fq) const {
        const int t0 = u.pm * 256, b = t0 >> 12, s0 = (t0 & 4095) + wr * 64 + 8 * fq;
#pragma unroll
        for (int ai = 0; ai < 2; ++ai)
#pragma unroll
            for (int mp = 0; mp < 2; ++mp) { const int s = s0 + ai * 128 + mp * 32;
                const f32x4 r0 = *(const f32x4*)(rstd1 + b * 4096 + s), r1 = *(const f32x4*)(rstd1 + b * 4096 + s + 4);
#pragma unroll
                for (int bj = 0; bj < 2; ++bj)
#pragma unroll
                    for (int n = 0; n < 2; ++n) { const int cg = (u.pn - 4) * 256 + bj * 128 + wc * 32 + 8 * (fr >> 2) + 4 * n + (fr & 3), g = cg >> 6, j = cg & 63;
                        const int plane = ((b * 8 + g) * 33 + (j <= 32 ? j : j - 32)) * 2 + (j <= 32 ? 0 : 1);
                        const f32x4 v0 = acc[ai][bj][2 * mp][n] * r0, v1 = acc[ai][bj][2 * mp + 1][n] * r1;
                        v4u w; w.x = pg8::cvt_pk_bf16(v0[0], v0[1]); w.y = pg8::cvt_pk_bf16(v0[2], v0[3]); w.z = pg8::cvt_pk_bf16(v1[0], v1[1]); w.w = pg8::cvt_pk_bf16(v1[2], v1[3]);
                        *(v4u*)(CF + (size_t)plane * 4096 + s) = w; } }
    }
};
struct EpiH {
    static constexpr bool PERM_A = false, DUAL = false;
    static constexpr int PERM = 1; static constexpr bool PREFETCH = false; static constexpr int SCALE_A = 0, SCALE_B = 0;
    const bf16* XB; bf16* HB; float* SSP; unsigned char* HB8;
    __device__ __forceinline__ void operator()(const f32x4 (&acc)[2][2][4][2], const pg8::Unit& u, int wr, int wc, int fr, int fq) const {
        const int row0 = u.pm * 256 + wr * 64 + fr, col0 = u.pn * 256 + wc * 32 + 8 * fq;
#pragma unroll
        for (int ai = 0; ai < 2; ++ai)
#pragma unroll
            for (int m = 0; m < 4; ++m) { const int row = row0 + ai * 128 + m * 16; const size_t off = (size_t)row * D + col0; float ss = 0.f;
#pragma unroll
                for (int bj = 0; bj < 2; ++bj) { const v4u xw = __builtin_nontemporal_load((const v4u*)(XB + off + bj * 128));
                    const f32x4 x0 = (f32x4){bflo(xw.x), bfhi(xw.x), bflo(xw.y), bfhi(xw.y)}, x1 = (f32x4){bflo(xw.z), bfhi(xw.z), bflo(xw.w), bfhi(xw.w)};
                    const f32x4 v0 = acc[ai][bj][m][0] + x0, v1 = acc[ai][bj][m][1] + x1;
                    v4u w; w.x = pg8::cvt_pk_bf16(v0[0], v0[1]); w.y = pg8::cvt_pk_bf16(v0[2], v0[3]); w.z = pg8::cvt_pk_bf16(v1[0], v1[1]); w.w = pg8::cvt_pk_bf16(v1[2], v1[3]);
                    const float r0 = bflo(w.x), r1 = bfhi(w.x), r2 = bflo(w.y), r3 = bfhi(w.y), r4 = bflo(w.z), r5 = bfhi(w.z), r6 = bflo(w.w), r7 = bfhi(w.w);
                    ss += ((r0 * r0 + r1 * r1) + (r2 * r2 + r3 * r3)) + ((r4 * r4 + r5 * r5) + (r6 * r6 + r7 * r7));
                    *(v4u*)(HB + off + bj * 128) = w;
                    int q0 = __builtin_amdgcn_cvt_pk_fp8_f32(sat8(r0), sat8(r1), 0, false); q0 = __builtin_amdgcn_cvt_pk_fp8_f32(sat8(r2), sat8(r3), q0, true);
                    int q1 = __builtin_amdgcn_cvt_pk_fp8_f32(sat8(r4), sat8(r5), 0, false); q1 = __builtin_amdgcn_cvt_pk_fp8_f32(sat8(r6), sat8(r7), q1, true);
                    *(v2u*)(HB8 + off + bj * 128) = (v2u){(unsigned)q0, (unsigned)q1}; }
                ss = xor32_sum(xor16_sum(ss));
                if (fq == 0) SSP[(size_t)row * 16 + u.pn * 4 + wc] = ss; }
    }
};
struct EpiGU {
    static constexpr bool PERM_A = false, DUAL = false;
    static constexpr int PERM = 1; static constexpr bool PREFETCH = false;
    static constexpr int SCALE_A = 0x7F7F7F7F, SCALE_B = 0x79797979;
    const float* rsl; const float* rstd2; unsigned char* hact; const volatile LAS int* bst;
    __device__ __forceinline__ void operator()(const f32x4 (&acc)[2][2][4][2], const pg8::Unit& u, int wr, int wc, int fr, int fq) const {
        const int blk = bst[u.e] + u.pm; unsigned char* H = hact + (size_t)blk * 65536;
        const int col0 = u.pn * 128 + wc * 32 + 8 * fq;
        const float* rp = (u.e < 64) ? rsl + (size_t)u.e * 32768 + u.pm * 256 : rstd2 + u.pm * 256;
        float rsv[8];
#pragma unroll
        for (int q = 0; q < 8; ++q) rsv[q] = rp[(q >> 2) * 128 + wr * 64 + (q & 3) * 16 + fr];
#pragma unroll
        for (int ai = 0; ai < 2; ++ai)
#pragma unroll
            for (int mp = 0; mp < 2; ++mp) { unsigned pw[2][2];
#pragma unroll
                for (int mm = 0; mm < 2; ++mm) { const int m = 2 * mp + mm; const float rs = rsv[ai * 4 + m];
                    const f32x4 g0 = acc[ai][0][m][0] * rs, g1 = acc[ai][0][m][1] * rs, u0 = acc[ai][1][m][0] * (rs * HSCALE), u1 = acc[ai][1][m][1] * (rs * HSCALE);
                    float hv[8];
#pragma unroll
                    for (int j = 0; j < 4; ++j) { hv[j] = sat8(g0[j] * __builtin_amdgcn_rcpf(1.0f + __builtin_amdgcn_exp2f(-1.44269504f * g0[j])) * u0[j]); hv[4 + j] = sat8(g1[j] * __builtin_amdgcn_rcpf(1.0f + __builtin_amdgcn_exp2f(-1.44269504f * g1[j])) * u1[j]); }
                    int p0 = __builtin_amdgcn_cvt_pk_fp8_f32(hv[0], hv[1], 0, false); p0 = __builtin_amdgcn_cvt_pk_fp8_f32(hv[2], hv[3], p0, true);
                    int p1 = __builtin_amdgcn_cvt_pk_fp8_f32(hv[4], hv[5], 0, false); p1 = __builtin_amdgcn_cvt_pk_fp8_f32(hv[6], hv[7], p1, true);
                    pw[mm][0] = (unsigned)p0; pw[mm][1] = (unsigned)p1; }
                const auto s0 = __builtin_amdgcn_permlane16_swap(pw[0][0], pw[1][0], false, false);
                const auto s1 = __builtin_amdgcn_permlane16_swap(pw[0][1], pw[1][1], false, false);
                const int r = ai * 128 + wr * 64 + (2 * mp + (fq & 1)) * 16 + fr;
                *(v4u*)(H + (size_t)r * 256 + u.pn * 128 + wc * 32 + 16 * (fq >> 1)) = (v4u){(unsigned)s0[0], (unsigned)s1[0], (unsigned)s0[1], (unsigned)s1[1]}; }
    }
};
struct EpiDN {
    static constexpr int PERM = 2;
    static constexpr bool PREFETCH = false; static constexpr int SCALE_A = 0x7C7C7C7C, SCALE_B = 0x79797979;
    const int* list; const float* gates; unsigned char* contrib; unsigned char* contrib9; unsigned char* trash;
    __device__ __forceinline__ void prefetch(const pg8::Unit& u, int wr, int fr, int fq, unsigned (&sgq)[2]) const {
        const unsigned* lp = (const unsigned*)list + (size_t)(u.e < 64 ? u.e : 0) * 32768 + u.pm * 256;
        sgq[0] = lp[wr * 64 + fq * 16 + fr]; sgq[1] = lp[128 + wr * 64 + fq * 16 + fr];
    }
    __device__ __forceinline__ void operator()(const f32x4 (&acc)[2][2][4][2], const pg8::Unit& u, int wr, int wc, int fr, int fq) const {
        unsigned sgp[8];
        { const unsigned* lp = (const unsigned*)list + (size_t)(u.e < 64 ? u.e : 0) * 32768 + u.pm * 256;
#pragma unroll
          for (int q = 0; q < 8; ++q) sgp[q] = lp[(q >> 2) * 128 + wr * 64 + (q & 3) * 16 + fr]; }
        const int col0 = u.pn * 256 + wc * 32 + 16 * (fq & 1) + 128 * (fq >> 1); const bool routed = u.e < 64;
#pragma unroll
        for (int ai = 0; ai < 2; ++ai) {
#pragma unroll
            for (int m = 0; m < 4; ++m) { const int r = ai * 128 + wr * 64 + m * 16 + fr; const float gs = routed ? (float)(sgp[ai * 4 + m] & 16383u) * (2.5f * CSCALE / 16383.0f) : CSCALE;
                unsigned char* cp = routed ? contrib + (size_t)(sgp[ai * 4 + m] >> 14) * 1024 : contrib9 + (size_t)(u.pm * 256 + r) * 1024;
                cp = (r < u.nvalid) ? cp : trash; cp += col0;
                unsigned pk[2][2];
#pragma unroll
                for (int bj = 0; bj < 2; ++bj) { const f32x4 v0 = acc[ai][bj][m][0] * gs, v1 = acc[ai][bj][m][1] * gs;
                    int p0 = __builtin_amdgcn_cvt_pk_fp8_f32(v0[0], v0[1], 0, false); p0 = __builtin_amdgcn_cvt_pk_fp8_f32(v0[2], v0[3], p0, true);
                    int p1 = __builtin_amdgcn_cvt_pk_fp8_f32(v1[0], v1[1], 0, false); p1 = __builtin_amdgcn_cvt_pk_fp8_f32(v1[2], v1[3], p1, true);
                    pk[bj][0] = (unsigned)p0; pk[bj][1] = (unsigned)p1; }
                const auto s0 = __builtin_amdgcn_permlane32_swap(pk[0][0], pk[1][0], false, false);
                const auto s1 = __builtin_amdgcn_permlane32_swap(pk[0][1], pk[1][1], false, false);
                *(v4u*)cp = (v4u){s0[0], s1[0], s0[1], s1[1]}; }
            asm volatile("" ::: "memory"); }
    }
};

__device__ __forceinline__ void p0_transpose_item(const float* W, int K, int N, bf16* WT, int row_off_n0, const float* ksc, LAS float* scr, int kb, int nb, int) {
    const int lane = lane_id();
    const int k0 = 64 * kb, n0 = 32 * nb;
    { f32x4 ld[8];
#pragma unroll
      for (int i = 0; i < 8; ++i) ld[i] = __builtin_nontemporal_load((const f32x4*)(W + (size_t)(k0 + 8 * i + (lane >> 3)) * N + n0 + 4 * (lane & 7)));
#pragma unroll
      for (int i = 0; i < 8; ++i) { LAS float* d_ = scr + (8 * i + (lane >> 3)) * 33 + 4 * (lane & 7); d_[0] = ld[i].x; d_[1] = ld[i].y; d_[2] = ld[i].z; d_[3] = ld[i].w; } }
    LDS_WAIT(); asm volatile("" ::: "memory");
    const int c = lane & 7;
    float sc[8];
#pragma unroll
    for (int q = 0; q < 8; ++q) sc[q] = ksc ? ksc[k0 + 8 * c + q] : 1.0f;
#pragma unroll
    for (int j = 0; j < 4; ++j) { const int n = (lane >> 3) + 8 * j; const LAS float* s = scr + (8 * c) * 33 + n;
        v4u o; o.x = pk2(s[0 * 33] * sc[0], s[1 * 33] * sc[1]); o.y = pk2(s[2 * 33] * sc[2], s[3 * 33] * sc[3]); o.z = pk2(s[4 * 33] * sc[4], s[5 * 33] * sc[5]); o.w = pk2(s[6 * 33] * sc[6], s[7 * 33] * sc[7]);
        *(v4u*)(WT + (size_t)(row_off_n0 + n) * K + k0 + 8 * c) = o; }
    LDS_WAIT(); asm volatile("" ::: "memory");
}
__device__ __forceinline__ void p0_transpose_item8(const float* W, int K, int N, unsigned char* WT, int row_off_n0, const float* ksc, LAS float* scr, int kb, int nb, int) {
    const int lane = lane_id();
    const int k0 = 128 * kb, n0 = 32 * nb;
    { f32x4 ld[16];
#pragma unroll
      for (int i = 0; i < 16; ++i) ld[i] = __builtin_nontemporal_load((const f32x4*)(W + (size_t)(k0 + 8 * i + (lane >> 3)) * N + n0 + 4 * (lane & 7)));
#pragma unroll
      for (int i = 0; i < 16; ++i) { const int kk = 8 * i + (lane >> 3), c = 4 * (lane & 7), x_ = kk & 31;
          scr[kk * 32 + ((c + 0) ^ x_)] = ld[i].x; scr[kk * 32 + ((c + 1) ^ x_)] = ld[i].y; scr[kk * 32 + ((c + 2) ^ x_)] = ld[i].z; scr[kk * 32 + ((c + 3) ^ x_)] = ld[i].w; } }
    LDS_WAIT(); asm volatile("" ::: "memory");
    const int c8 = lane & 7;
    float sc[16];
#pragma unroll
    for (int q = 0; q < 16; ++q) sc[q] = (ksc ? ksc[k0 + 16 * c8 + q] : 1.0f) * WSCALE;
#pragma unroll 1
    for (int j = 0; j < 4; ++j) { const int n = (lane >> 3) + 8 * j; float v[16];
#pragma unroll
        for (int q = 0; q < 16; ++q) { const int kk = 16 * c8 + q; v[q] = scr[kk * 32 + (n ^ (kk & 31))] * sc[q]; }
        unsigned w[4];
#pragma unroll
        for (int q = 0; q < 4; ++q) { int p = __builtin_amdgcn_cvt_pk_fp8_f32(v[4 * q], v[4 * q + 1], 0, false); p = __builtin_amdgcn_cvt_pk_fp8_f32(v[4 * q + 2], v[4 * q + 3], p, true); w[q] = (unsigned)p; }
        *(v4u*)(WT + (size_t)(row_off_n0 + n) * K + k0 + 16 * c8) = (v4u){w[0], w[1], w[2], w[3]}; }
    LDS_WAIT(); asm volatile("" ::: "memory");
}
__device__ __forceinline__ void p0_prologue(Frame& F) {
    LAS float* scr = (LAS float*)(F.lds + F.wave * 16384);
    const int gw = F.c * NWAVES + F.wave, NGW = F.G * NWAVES, lane = lane_id();
    constexpr int I_IN = 16 * 32, I_OUT = 16 * 32, I_R = 16 * 2, I_G = 64 * 64, I_D = 64 * 64, I_S = 64, I_F = 8 * 64;
    constexpr int NITEMS = I_IN + I_OUT + I_R + 2 * I_G + I_D + 3 * I_S + I_F;
    unsigned char* WguT = WSP(unsigned char, WS_WGU); unsigned char* WdT = WSP(unsigned char, WS_WD);
    for (int it = gw; it < NITEMS; it += NGW) {
        int r = it;
        if (r < I_IN) { p0_transpose_item(karg_in(2), 1024, 1536, WSP(bf16, WS_WIN), (r & 31) * 32, karg_in(1), scr, r >> 5, r & 31, lane); continue; } r -= I_IN;
        if (r < I_OUT) { p0_transpose_item(karg_in(9), 1024, 1024, WSP(bf16, WS_WOUT), (r % 32) * 32, nullptr, scr, r / 32, r % 32, lane); continue; } r -= I_OUT;
        if (r < I_R) { p0_transpose_item(karg_in(11), 1024, 64, WSP(bf16, WS_WR), (r % 2) * 32, karg_in(10), scr, r / 2, r % 2, lane); continue; } r -= I_R;
        if (r < 2 * I_G) { const int up = r >= I_G; if (up) r -= I_G; const int e = r >> 6, q = r & 63, kb = q >> 3, nb = q & 7, n0 = nb * 32;
            p0_transpose_item8((up ? karg_in(14) : karg_in(13)) + (size_t)e * 1024 * 256, 1024, 256, WguT + (size_t)e * 512 * 1024, (n0 >> 7) * 256 + up * 128 + (n0 & 127), karg_in(10), scr, kb, nb, lane); continue; } r -= 2 * I_G;
        if (r < I_D) { const int e = r >> 6, q = r & 63, kb = q >> 5, nb = q & 31;
            p0_transpose_item8(karg_in(15) + (size_t)e * 256 * 1024, 256, 1024, WdT + (size_t)e * 1024 * 256, nb * 32, nullptr, scr, kb, nb, lane); continue; } r -= I_D;
        if (r < 2 * I_S) { const int up = r >= I_S; if (up) r -= I_S; const int kb = r >> 3, nb = r & 7, n0 = nb * 32;
            p0_transpose_item8(up ? karg_in(17) : karg_in(16), 1024, 256, WguT + (size_t)64 * 512 * 1024, (n0 >> 7) * 256 + up * 128 + (n0 & 127), karg_in(10), scr, kb, nb, lane); continue; } r -= 2 * I_S;
        if (r < I_S) { const int kb = r >> 5, nb = r & 31; p0_transpose_item8(karg_in(18), 256, 1024, WdT + (size_t)64 * 1024 * 256, nb * 32, nullptr, scr, kb, nb, lane); continue; } r -= I_S;
        {
            const int g = r >> 6, k0 = 16 * (r & 63), n0 = 1024 + 64 * g, ln2 = lane_id();
            const float* src = karg_in(2) + (size_t)k0 * 1536 + n0 + ln2; const float* g1 = karg_in(1) + k0;
            float xv[16];
#pragma unroll
            for (int i = 0; i < 16; ++i) xv[i] = src[(size_t)i * 1536];
            { float sn, cs; sincospif((float)ln2 * (1.0f / 32.0f), &sn, &cs); scr[1024 + ln2] = cs; scr[1088 + ln2] = sn; }
#pragma unroll
            for (int p = 0; p < 4; ++p) *(LAS f32x4*)(scr + ln2 * 16 + 4 * p) = (f32x4){xv[4 * p] * g1[4 * p], xv[4 * p + 1] * g1[4 * p + 1], xv[4 * p + 2] * g1[4 * p + 2], xv[4 * p + 3] * g1[4 * p + 3]};
            LDS_WAIT(); asm volatile("" ::: "memory");
            const int mm = ln2 <= 32 ? ln2 : ln2 - 32;
            float o[16];
#pragma unroll
            for (int q = 0; q < 16; ++q) o[q] = 0.f;
#pragma unroll 8
            for (int c = 0; c < 64; ++c) { const int ix = (mm * c) & 63; const float cs = scr[1024 + ix], sn = scr[1088 + ix]; const float tmc = ln2 <= 32 ? cs : -sn;
#pragma unroll
                for (int p = 0; p < 4; ++p) { const f32x4 rv = *(const LAS f32x4*)(scr + c * 16 + 4 * p); o[4 * p] += rv.x * tmc; o[4 * p + 1] += rv.y * tmc; o[4 * p + 2] += rv.z * tmc; o[4 * p + 3] += rv.w * tmc; } }
            bf16* dst = WSP(bf16, WS_WIN) + (size_t)(n0 + ln2) * 1024 + k0;
            *(v4u*)dst = (v4u){pk2(o[0], o[1]), pk2(o[2], o[3]), pk2(o[4], o[5]), pk2(o[6], o[7])};
            *(v4u*)(dst + 8) = (v4u){pk2(o[8], o[9]), pk2(o[10], o[11]), pk2(o[12], o[13]), pk2(o[14], o[15])};
            LDS_WAIT(); asm volatile("" ::: "memory");
        }
    }
    bf16* XN = WSP(bf16, WS_XN);
    float* RSTD1 = WSP(float, WS_RSTD1);
    for (int m0 = gw * 2; m0 < T; m0 += NGW * 2) {
        f32x4 v[2][4];
#pragma unroll
        for (int r = 0; r < 2; ++r) { const f32x4* xr = (const f32x4*)(karg_in(0) + (size_t)(m0 + r) * D) + lane;
#pragma unroll
            for (int j = 0; j < 4; ++j) v[r][j] = __builtin_nontemporal_load(xr + 64 * j); }
#pragma unroll
        for (int r = 0; r < 2; ++r) { float sq = 0.f; unsigned long long* o8 = (unsigned long long*)(XN + (size_t)(m0 + r) * D) + lane;
#pragma unroll
            for (int j = 0; j < 4; ++j) { sq += (v[r][j].x * v[r][j].x + v[r][j].y * v[r][j].y) + (v[r][j].z * v[r][j].z + v[r][j].w * v[r][j].w);
                o8[64 * j] = (unsigned long long)pk2(v[r][j].x, v[r][j].y) | ((unsigned long long)pk2(v[r][j].z, v[r][j].w) << 32); }
            const float rstd = 1.0f / sqrtf(wave_sum(sq) * (1.f / D) + EPS);
            if (lane == 0) RSTD1[m0 + r] = rstd; }
    }
    const int gt = F.c * 512 + (F.wave * 64 + lane_id()), NGT = F.G * 512;
    bf16* WSB = WSP(bf16, WS_WSB);
    for (int i = gt; i < 8 * 128 * 128; i += NGT) WSB[i] = (bf16)f2bf(karg_in(5)[i]);
    { unsigned char* IMG = WSP(unsigned char, WS_F2IMG);
      for (int i = gt; i < 128 * 128 + 64 * 128 + 2048; i += NGT) {
        if (i < 128 * 128) { const int r = i >> 7, c = i & 127, pp = r >> 6, k1 = r & 63, p = c >> 6, s1 = c & 63; float sn, cs; sincospif((float)((k1 * s1) & 63) * (1.0f / 32.0f), &sn, &cs);
            const float v = pp == 0 ? (p == 0 ? cs : sn) : (p == 0 ? -sn : cs); *(bf16*)(IMG + FB_OFF + r * FPITCH + c * 2) = (bf16)f2bf(v); }
        else if (i < 128 * 128 + 64 * 128) { const int j = i - 128 * 128, k2 = j >> 7, c = j & 127, p = c >> 6, s2 = c & 63; float sn, cs; sincospif((float)((k2 * s2) & 63) * (1.0f / 32.0f), &sn, &cs);
            *(bf16*)(IMG + GT_OFF + k2 * FPITCH + c * 2) = (bf16)f2bf(p == 0 ? cs : sn); }
        else { const int j = i - 128 * 128 - 64 * 128; float sn, cs; sincospif((float)j * (2.0f / 4096.0f), &sn, &cs); *(f32x2*)(IMG + TWL_OFF + j * 8) = (f32x2){cs, -sn}; } } }
    { bf16* CF = WSP(bf16, WS_CF);
      for (int i = gt; i < 64 * 2 * 512; i += NGT) { const int bg = i >> 10, m = ((i >> 9) & 1) * 32, o = i & 511; *(v4u*)(CF + ((size_t)(bg * 33 + m) * 2 + 1) * 4096 + o * 8) = (v4u){0u, 0u, 0u, 0u}; } }
    f32x2* TW = WSP(f32x2, WS_TW);
    for (int i = gt; i < 2048 + 64; i += NGT) {
        if (i < 2048) { float s, c; sincospif((float)i * (2.0f / 4096.0f), &s, &c); TW[i] = (f32x2){c, -s}; }
        else { const int j = i - 2048; float s, c; sincospif((float)j * (2.0f / 64.0f), &s, &c); TW[2048 + j] = (f32x2){c, s}; }
    }
}

constexpr int VN_PITCH = 272;
__host__ __device__ __forceinline__ int sgu_row(int c) { return 16 * (2 * (c >> 5) + ((c >> 2) & 1)) + 4 * ((c >> 3) & 3) + (c & 3); }
__device__ __forceinline__ void sgu_item(Frame& F, int item) {
    const int t0 = item * 128, lane = lane_id(), h = F.wave, fr = lane & 15, fq = lane >> 4;
    const bf16* Z = WSP(const bf16, WS_Z) + (size_t)t0 * DIN;
    LAS unsigned char* vnT = F.lds;
    LAS float* ssq = (LAS float*)(F.lds + 512 * VN_PITCH + 1024);
    { v4u wv[16];
#pragma unroll
      for (int r = 0; r < 16; ++r) wv[r] = __builtin_nontemporal_load((const v4u*)(Z + (size_t)(16 * h + r) * DIN + 512 + lane * 8));
      float gch[8], bch[8];
      { const f32x4 ga = *(const f32x4*)(karg_in(3) + lane * 8), gb = *(const f32x4*)(karg_in(3) + lane * 8 + 4), ba = *(const f32x4*)(karg_in(4) + lane * 8), bb = *(const f32x4*)(karg_in(4) + lane * 8 + 4);
        gch[0] = ga.x; gch[1] = ga.y; gch[2] = ga.z; gch[3] = ga.w; gch[4] = gb.x; gch[5] = gb.y; gch[6] = gb.z; gch[7] = gb.w;
        bch[0] = ba.x; bch[1] = ba.y; bch[2] = ba.z; bch[3] = ba.w; bch[4] = bb.x; bch[5] = bb.y; bch[6] = bb.z; bch[7] = bb.w; }
#pragma unroll
      for (int rb = 0; rb < 2; ++rb) { unsigned o[8][4];
#pragma unroll
        for (int rr = 0; rr < 8; ++rr) { const v4u w = wv[rb * 8 + rr];
            float v[8] = {bflo(w.x), bfhi(w.x), bflo(w.y), bfhi(w.y), bflo(w.z), bfhi(w.z), bflo(w.w), bfhi(w.w)}; float s1 = 0.f;
#pragma unroll
            for (int j = 0; j < 8; ++j) s1 += v[j];
            const float mean = wave_sum(s1) * (1.f / 512.f); float s2 = 0.f;
#pragma unroll
            for (int j = 0; j < 8; ++j) { v[j] -= mean; s2 += v[j] * v[j]; }
            const float rstd = 1.0f / sqrtf(wave_sum(s2) * (1.f / 512.f) + EPS);
#pragma unroll
            for (int j = 0; j < 8; ++j) { const unsigned bits = f2bf(v[j] * rstd * gch[j] + bch[j]); if (rr & 1) o[j][rr >> 1] |= bits << 16; else o[j][rr >> 1] = bits; } }
        const int hh = lane >> 3, cl = (lane & 7) * 8;
#pragma unroll
        for (int j = 0; j < 8; ++j) *(LAS v4u*)(vnT + (hh * 64 + sgu_row(cl + j)) * VN_PITCH + (16 * h + rb * 8) * 2) = (v4u){o[j][0], o[j][1], o[j][2], o[j][3]}; } }
    LDS_BARRIER();
    const bf16* WSB = WSP(const bf16, WS_WSB) + (size_t)h * 128 * 128;
    bf16* MIX = WSP(bf16, WS_MIX) + (size_t)t0 * D;
    bf16x8 Xf[4][4];
#pragma unroll
    for (int ks = 0; ks < 4; ++ks)
#pragma unroll
        for (int dt = 0; dt < 4; ++dt) Xf[ks][dt] = *(const LAS bf16x8*)(vnT + (h * 64 + dt * 16 + fr) * VN_PITCH + (ks * 32 + fq * 8) * 2);
    unsigned ypk[8][8];
    bf16x8 Yc[4], Yn[4]; v4u uc[2], un[2];
#pragma unroll
    for (int ks = 0; ks < 4; ++ks) Yc[ks] = *(const bf16x8*)(WSB + (size_t)fr * 128 + ks * 32 + fq * 8);
#pragma unroll
    for (int t = 0; t < 2; ++t) uc[t] = __builtin_nontemporal_load((const v4u*)(Z + (size_t)fr * DIN + h * 64 + 32 * t + 8 * fq));
#pragma unroll
    for (int pt = 0; pt < 8; ++pt) {
        if (pt < 7) {
#pragma unroll
            for (int ks = 0; ks < 4; ++ks) Yn[ks] = *(const bf16x8*)(WSB + (size_t)((pt + 1) * 16 + fr) * 128 + ks * 32 + fq * 8);
#pragma unroll
            for (int t = 0; t < 2; ++t) un[t] = __builtin_nontemporal_load((const v4u*)(Z + (size_t)((pt + 1) * 16 + fr) * DIN + h * 64 + 32 * t + 8 * fq)); }
        f32x4 acc[4];
#pragma unroll
        for (int dt = 0; dt < 4; ++dt) acc[dt] = (f32x4){0.f, 0.f, 0.f, 0.f};
#pragma unroll
        for (int ks = 0; ks < 4; ++ks) {
#pragma unroll
            for (int dt = 0; dt < 4; ++dt) acc[dt] = __builtin_amdgcn_mfma_f32_16x16x32_bf16(Xf[ks][dt], Yc[ks], acc[dt], 0, 0, 0); }
        const int p = pt * 16 + fr; const float bias = karg_in(6)[h * 128 + p]; float ss = 0.f;
#pragma unroll
        for (int t = 0; t < 2; ++t) { const v4u uw = uc[t]; const f32x4 a0 = acc[2 * t], a1 = acc[2 * t + 1];
            const float y0 = bflo(uw.x) * (a0[0] + bias), y1 = bfhi(uw.x) * (a0[1] + bias), y2 = bflo(uw.y) * (a0[2] + bias), y3 = bfhi(uw.y) * (a0[3] + bias);
            const float y4 = bflo(uw.z) * (a1[0] + bias), y5 = bfhi(uw.z) * (a1[1] + bias), y6 = bflo(uw.w) * (a1[2] + bias), y7 = bfhi(uw.w) * (a1[3] + bias);
            ss += ((y0 * y0 + y1 * y1) + (y2 * y2 + y3 * y3)) + ((y4 * y4 + y5 * y5) + (y6 * y6 + y7 * y7));
            ypk[pt][4 * t + 0] = pk2(y0, y1); ypk[pt][4 * t + 1] = pk2(y2, y3); ypk[pt][4 * t + 2] = pk2(y4, y5); ypk[pt][4 * t + 3] = pk2(y6, y7); }
        ss = xor32_sum(xor16_sum(ss)); if (fq == 0) ssq[p * 8 + h] = ss;
        __builtin_amdgcn_sched_barrier(0);
#pragma unroll
        for (int ks = 0; ks < 4; ++ks) Yc[ks] = Yn[ks];
        uc[0] = un[0]; uc[1] = un[1];
    }
    LDS_BARRIER();
#pragma unroll
    for (int pt = 0; pt < 8; ++pt) { const int p = pt * 16 + fr; float tot = 0.f;
#pragma unroll
        for (int j = 0; j < 8; ++j) tot += ssq[p * 8 + j];
        const float rstd = 1.0f / sqrtf(tot * (1.f / 512.f) + EPS);
#pragma unroll
        for (int t = 0; t < 2; ++t) { const int ch = h * 64 + 32 * t + 8 * fq; const f32x4 g0 = *(const f32x4*)(karg_in(7) + ch), g1 = *(const f32x4*)(karg_in(7) + ch + 4);
            const unsigned w0 = ypk[pt][4 * t], w1 = ypk[pt][4 * t + 1], w2 = ypk[pt][4 * t + 2], w3 = ypk[pt][4 * t + 3];
            *(v4u*)(MIX + (size_t)p * D + ch) = (v4u){pk2(bflo(w0) * rstd * g0.x, bfhi(w0) * rstd * g0.y), pk2(bflo(w1) * rstd * g0.z, bfhi(w1) * rstd * g0.w),
                                                     pk2(bflo(w2) * rstd * g1.x, bfhi(w2) * rstd * g1.y), pk2(bflo(w3) * rstd * g1.z, bfhi(w3) * rstd * g1.w)}; } }
    LDS_BARRIER();
}
__device__ __forceinline__ void f1_item(Frame& F, int item) {
    const int t0 = item * 64, b = t0 >> 12, s0 = t0 & 4095, tid = (F.wave * 64 + lane_id()), lane = lane_id(), g = F.wave;
    const bf16* Z = WSP(const bf16, WS_Z) + (size_t)t0 * DIN + 1024;
    LAS float* zt = (LAS float*)F.lds;
#pragma unroll
    for (int i = 0; i < 8; ++i) { const int idx = tid + 512 * i, tok = idx >> 6, c8 = idx & 63; const v4u w = __builtin_nontemporal_load((const v4u*)(Z + (size_t)tok * DIN + c8 * 8)); LAS float* d = zt + tok * 513 + c8 * 8;
        d[0] = bflo(w.x); d[1] = bfhi(w.x); d[2] = bflo(w.y); d[3] = bfhi(w.y); d[4] = bflo(w.z); d[5] = bfhi(w.z); d[6] = bflo(w.w); d[7] = bfhi(w.w); }
    LDS_BARRIER();
    bf16* CF = WSP(bf16, WS_CF) + ((size_t)(b * 8 + g) * 33) * 8192 + s0 + lane;
    const LAS float* zr = zt + lane * 513 + g * 64;
#pragma unroll
    for (int m = 0; m <= 32; ++m) { const float re = zr[m], im = (m >= 1 && m <= 31) ? zr[32 + m] : 0.f; CF[(size_t)m * 8192] = (bf16)f2bf(re); CF[(size_t)m * 8192 + 4096] = (bf16)f2bf(im); }
    LDS_BARRIER();
}
typedef short s16x4 __attribute__((ext_vector_type(4)));
__device__ __forceinline__ void f2_phase(Frame& F) {
    LAS unsigned char* L = F.lds; const int tid = (F.wave * 64 + lane_id()), lane = lane_id(), wave = F.wave, l15 = lane & 15, kg = lane >> 4;
    { const v4u* IMG = WSP(const v4u, WS_F2IMG); for (int i = tid; i < XI_OFF / 16; i += 512) *(LAS v4u*)(L + i * 16) = IMG[i]; }
    const LAS f32x2* TWL = (const LAS f32x2*)(L + TWL_OFF);
    const bf16* CF = WSP(const bf16, WS_CF);
    int col = F.c; v4u pre[2];
    if (col < NCOLF) { pre[0] = __builtin_nontemporal_load((const v4u*)(CF + (size_t)col * 8192 + tid * 8)); pre[1] = __builtin_nontemporal_load((const v4u*)(CF + (size_t)col * 8192 + 4096 + tid * 8)); }
    LDS_BARRIER();
    const int mt = wave & 3, pg = wave >> 2;
    for (int buf = 0; col < NCOLF; col += F.G, buf ^= 1) {
        LAS unsigned char* XI = L + XI_OFF + buf * XI_SZ;
        *(LAS v4u*)(XI + (tid >> 3) * XPITCH + (tid & 7) * 16) = pre[0]; *(LAS v4u*)(XI + (64 + (tid >> 3)) * XPITCH + (tid & 7) * 16) = pre[1];
        if (col + F.G < NCOLF) { pre[0] = __builtin_nontemporal_load((const v4u*)(CF + (size_t)(col + F.G) * 8192 + tid * 8)); pre[1] = __builtin_nontemporal_load((const v4u*)(CF + (size_t)(col + F.G) * 8192 + 4096 + tid * 8)); }
        LDS_BARRIER();
        f32x4 acc[2][2];
#pragma unroll
        for (int a_ = 0; a_ < 2; ++a_)
#pragma unroll
            for (int b_ = 0; b_ < 2; ++b_) acc[a_][b_] = (f32x4){0.f, 0.f, 0.f, 0.f};
#pragma unroll
        for (int ks = 0; ks < 4; ++ks) {
            const int rowb = ks * 32 + 8 * kg + (l15 >> 2), colb = 16 * mt + 4 * (lane & 3);
            const s16x4 alo = __builtin_amdgcn_ds_read_tr16_b64_v4i16((LAS s16x4*)(XI + rowb * XPITCH + colb * 2));
            const s16x4 ahi = __builtin_amdgcn_ds_read_tr16_b64_v4i16((LAS s16x4*)(XI + (rowb + 4) * XPITCH + colb * 2));
            const bf16x8 A = __builtin_shufflevector(alo, ahi, 0, 1, 2, 3, 4, 5, 6, 7);
#pragma unroll
            for (int kt = 0; kt < 2; ++kt)
#pragma unroll
                for (int part = 0; part < 2; ++part) { const int jrow = part * 64 + (2 * pg + kt) * 16 + l15;
                    const bf16x8 B = *(const LAS bf16x8*)(L + FB_OFF + jrow * FPITCH + (ks * 32 + 8 * kg) * 2);
                    acc[kt][part] = __builtin_amdgcn_mfma_f32_16x16x32_bf16(A, B, acc[kt][part], 0, 0, 0); }
        }
#pragma unroll
        for (int kt = 0; kt < 2; ++kt) { const int k1 = (2 * pg + kt) * 16 + l15, s2b = 16 * mt + 4 * kg; float tr4[4], ti4[4];
#pragma unroll
            for (int r = 0; r < 4; ++r) { const int idx = k1 * (s2b + r); f32x2 w = TWL[idx & 2047]; if (idx >= 2048) w = -w;
                const float tr = acc[kt][0][r], ti = acc[kt][1][r]; tr4[r] = tr * w.x - ti * w.y; ti4[r] = tr * w.y + ti * w.x; }
            *(LAS v2u*)(L + TI_OFF + k1 * FPITCH + s2b * 2) = (v2u){pk2(tr4[0], tr4[1]), pk2(tr4[2], tr4[3])};
            *(LAS v2u*)(L + TI_OFF + k1 * FPITCH + (64 + s2b) * 2) = (v2u){pk2(ti4[0], ti4[1]), pk2(ti4[2], ti4[3])}; }
        LDS_BARRIER();
        f32x4 acc2[2] = {(f32x4){0.f, 0.f, 0.f, 0.f}, (f32x4){0.f, 0.f, 0.f, 0.f}};
#pragma unroll
        for (int ks = 0; ks < 4; ++ks) { const bf16x8 G2 = *(const LAS bf16x8*)(L + GT_OFF + (16 * mt + l15) * FPITCH + (ks * 32 + 8 * kg) * 2);
#pragma unroll
            for (int j = 0; j < 2; ++j) { const bf16x8 T2 = *(const LAS bf16x8*)(L + TI_OFF + ((2 * pg + j) * 16 + l15) * FPITCH + (ks * 32 + 8 * kg) * 2);
                acc2[j] = __builtin_amdgcn_mfma_f32_16x16x32_bf16(T2, G2, acc2[j], 0, 0, 0); } }
        float* dst = WSP(float, WS_YT) + (size_t)col * 4096;
#pragma unroll
        for (int j = 0; j < 2; ++j) *(f32x4*)(dst + (16 * mt + l15) * 64 + (2 * pg + j) * 16 + 4 * kg) = acc2[j] * (1.0f / 512.0f);
    }
    LDS_BARRIER();
}
__device__ __forceinline__ void f3_item(Frame& F, int item) {
    const int t0 = item * 64, b = t0 >> 12, k0 = t0 & 4095, lane = lane_id(), g = F.wave;
    LAS float* yt = (LAS float*)F.lds;
    const float* YT = WSP(const float, WS_YT) + ((size_t)(b * 8 + g) * 33) * 4096;
    { const int tq = lane & 15, cs = lane >> 4;
#pragma unroll
      for (int mb = 0; mb < 36; mb += 12) { f32x4 v[3], v2[3];
#pragma unroll
        for (int i = 0; i < 3; ++i) { const int m = mb + 4 * i + cs;
            const int mc = m <= 32 ? m : 32;
            v[i] = __builtin_nontemporal_load((const f32x4*)(YT + (size_t)mc * 4096 + k0 + 4 * tq));
            const int kb = 4096 - k0 - 4 * tq - 3;
            if (k0 + tq != 0) v2[i] = __builtin_nontemporal_load((const f32x4*)(YT + (size_t)mc * 4096 + kb));
            else { const float* yp = YT + (size_t)mc * 4096; v2[i] = (f32x4){yp[4093], yp[4094], yp[4095], yp[0]}; } }
#pragma unroll
        for (int i = 0; i < 3; ++i) { const int m = mb + 4 * i + cs;
            if (m <= 32) { LAS float* d_ = yt + (4 * tq) * 513 + g * 64 + m; d_[0] = v[i].x; d_[513] = v[i].y; d_[2 * 513] = v[i].z; d_[3 * 513] = v[i].w;
                if (m >= 1 && m <= 31) { LAS float* e_ = yt + (4 * tq) * 513 + g * 64 + 64 - m; e_[0] = v2[i].w; e_[513] = v2[i].z; e_[2 * 513] = v2[i].y; e_[3 * 513] = v2[i].x; } } } } }
    LDS_BARRIER();
    bf16* MIX = WSP(bf16, WS_MIX) + (size_t)t0 * D + 512;
    for (int r = 0; r < 8; ++r) { const int row = F.wave * 8 + r; float ss = 0.f;
#pragma unroll
        for (int j = 0; j < 8; ++j) { const float v = yt[row * 513 + lane + 64 * j]; ss += v * v; }
        const float rstd = 1.0f / sqrtf(wave_sum(ss) * (1.f / 512.f) + EPS);
        float v[8];
#pragma unroll
        for (int j = 0; j < 8; ++j) v[j] = yt[row * 513 + lane * 8 + j] * rstd * karg_in(8)[lane * 8 + j];
        *(v4u*)(MIX + (size_t)row * D + lane * 8) = (v4u){pk2(v[0], v[1]), pk2(v[2], v[3]), pk2(v[4], v[5]), pk2(v[6], v[7])}; }
    LDS_BARRIER();
}

constexpr int WR_PITCH = 2064;
__device__ __forceinline__ float red16_max(float v) { v = fmaxf(v, dpp_f<0xB1>(v)); v = fmaxf(v, dpp_f<0x4E>(v)); v = fmaxf(v, dpp_f<0x141>(v)); v = fmaxf(v, dpp_f<0x140>(v)); return v; }
__device__ __forceinline__ int red16_min(int v) { v = min(v, dpp_i<0xB1>(v)); v = min(v, dpp_i<0x4E>(v)); v = min(v, dpp_i<0x141>(v)); v = min(v, dpp_i<0x140>(v)); return v; }
__device__ __forceinline__ float red8_max(float v) { v = fmaxf(v, dpp_f<0xB1>(v)); v = fmaxf(v, dpp_f<0x4E>(v)); v = fmaxf(v, dpp_f<0x141>(v)); return v; }
__device__ __forceinline__ int red8_min(int v) { v = min(v, dpp_i<0xB1>(v)); v = min(v, dpp_i<0x4E>(v)); v = min(v, dpp_i<0x141>(v)); return v; }
__device__ __forceinline__ float red16_sum(float v) { return row16_sum(v); }
__device__ __forceinline__ void route_phase(Frame& F) {
    const int tid = (F.wave * 64 + lane_id()), lane = lane_id(), wave = F.wave, c16 = lane & 15, rg = lane >> 4;
    LAS unsigned char* wr = F.lds;
    LAS int* lcnt = (LAS int*)(F.lds + 64 * WR_PITCH);
    LAS int* gbase = lcnt + 64;
    const bf16* WR = WSP(const bf16, WS_WR);
    for (int i = tid; i < 64 * 128; i += 512) { const int e = i >> 7, ch = i & 127; *(LAS v4u*)(wr + e * WR_PITCH + ch * 16) = *(const v4u*)(WR + (size_t)e * 1024 + ch * 8); }
    LDS_BARRIER();
    const bf16* HB = WSP(const bf16, WS_HB); const float* SSP = WSP(const float, WS_SSP);
    float* RSTD2 = WSP(float, WS_RSTD2); float* RSL = WSP(float, WS_RSL); float* GL = WSP(float, WS_GL); int* LIST = WSP(int, WS_LIST); unsigned short* TOKP = WSP(unsigned short, WS_TOKP); unsigned* GCNT = F.ctl + CW_CNT;
    float bias[4];
#pragma unroll
    for (int nt = 0; nt < 4; ++nt) bias[nt] = karg_in(12)[nt * 16 + c16];
    for (int item = F.c; item < T / 128; item += F.G) {
        const int t0 = item * 128 + wave * 16;
        if (tid < 64) lcnt[tid] = 0;
        f32x4 acc[4];
#pragma unroll
        for (int nt = 0; nt < 4; ++nt) acc[nt] = (f32x4){0.f, 0.f, 0.f, 0.f};
        const bf16* arow = HB + (size_t)(t0 + c16) * D + rg * 8;
        v4u a_all[8][4];
#pragma unroll
        for (int blk = 0; blk < 8; ++blk)
#pragma unroll
            for (int s = 0; s < 4; ++s) a_all[blk][s] = __builtin_nontemporal_load((const v4u*)(arow + blk * 128 + s * 32));
#pragma unroll
        for (int blk = 0; blk < 8; ++blk) {
#pragma unroll
            for (int s = 0; s < 4; ++s) { const bf16x8 Af = __builtin_bit_cast(bf16x8, a_all[blk][s]);
#pragma unroll
                for (int nt = 0; nt < 4; ++nt) { const bf16x8 Bf = *(const LAS bf16x8*)(wr + (nt * 16 + c16) * WR_PITCH + (blk * 128 + s * 32 + rg * 8) * 2);
                    acc[nt] = __builtin_amdgcn_mfma_f32_16x16x32_bf16(Af, Bf, acc[nt], 0, 0, 0); } }
        }
        LDS_BARRIER();
        int sel_lpos[4][4]; int sel_k[4][4]; float sel_w[4][4]; float sel_rs[4];
#pragma unroll
        for (int r = 0; r < 4; ++r) {
            const int tok = t0 + 4 * rg + r;
            float part = SSP[(size_t)tok * 16 + c16]; part = red16_sum(part);
            const float rs = 1.0f / sqrtf(part * (1.f / D) + EPS);
            if (c16 == 0) RSTD2[tok] = rs;
            sel_rs[r] = rs;
            float sc[4], bv[4];
#pragma unroll
            for (int nt = 0; nt < 4; ++nt) { const float lg = acc[nt][r] * rs; sc[nt] = 1.0f / (1.0f + __expf(-lg)); bv[nt] = sc[nt] + bias[nt]; }
            float gs[4];
#pragma unroll
            for (int nt = 0; nt < 4; ++nt) { const float m1 = red8_max(bv[nt]); const int i1 = red8_min(bv[nt] == m1 ? (c16 & 7) : 99); const float v2 = ((c16 & 7) == i1) ? -INFINITY : bv[nt]; gs[nt] = m1 + red8_max(v2); }
            float G8[8];
#pragma unroll
            for (int nt = 0; nt < 4; ++nt) { const float og = dpp_f<0x140>(gs[nt]);     G8[2 * nt] = (c16 < 8) ? gs[nt] : og; G8[2 * nt + 1] = (c16 < 8) ? og : gs[nt]; }
            bool gsel[8];
#pragma unroll
            for (int j = 0; j < 8; ++j) { int rank = 0;
#pragma unroll
                for (int i = 0; i < 8; ++i) if (i != j) rank += (G8[i] > G8[j] || (G8[i] == G8[j] && i < j)) ? 1 : 0;
                gsel[j] = rank < 4; }
            float mv[4];
#pragma unroll
            for (int nt = 0; nt < 4; ++nt) { const bool s_ = (c16 < 8) ? gsel[2 * nt] : gsel[2 * nt + 1]; mv[nt] = s_ ? bv[nt] : -INFINITY; }
            bool picked[4] = {false, false, false, false}; int pk_k[4] = {0, 0, 0, 0}; float wsum = 0.f;
#pragma unroll
            for (int k = 0; k < 8; ++k) {
                float lm = fmaxf(fmaxf(mv[0], mv[1]), fmaxf(mv[2], mv[3])); const float gm = red16_max(lm);
                int li = 999;
#pragma unroll
                for (int nt = 3; nt >= 0; --nt) if (mv[nt] == gm) li = nt * 16 + c16;
                const int gi = red16_min(li);
#pragma unroll
                for (int nt = 0; nt < 4; ++nt) if (gi == nt * 16 + c16) { picked[nt] = true; pk_k[nt] = k; mv[nt] = -INFINITY; wsum += sc[nt]; }
            }
            wsum = red16_sum(wsum);
            const float wn = 2.5f / wsum;
#pragma unroll
            for (int nt = 0; nt < 4; ++nt) { sel_lpos[r][nt] = -1; sel_k[r][nt] = pk_k[nt]; sel_w[r][nt] = sc[nt] * wn;
                if (picked[nt]) sel_lpos[r][nt] = __hip_atomic_fetch_add(&lcnt[nt * 16 + c16], 1, __ATOMIC_RELAXED, __HIP_MEMORY_SCOPE_WORKGROUP); }
        }
        LDS_BARRIER();
        if (tid < 64) gbase[tid] = (int)atomicAdd(&GCNT[tid], (unsigned)lcnt[tid]);
        LDS_BARRIER();
        LAS int* ent = (LAS int*)(F.lds + 64 * WR_PITCH + 1024);
#pragma unroll
        for (int r = 0; r < 4; ++r) { const int tl = wave * 16 + 4 * rg + r, tok = item * 128 + tl;
#pragma unroll
            for (int nt = 0; nt < 4; ++nt) if (sel_lpos[r][nt] >= 0) { const int e = nt * 16 + c16, k = sel_k[r][nt], slot = tok * 8 + k, ix = (tl * 8 + k) * 3;
                ent[ix] = e * 32768 + gbase[e] + sel_lpos[r][nt]; ent[ix + 1] = (int)(((unsigned)slot << 14) | (unsigned)(sel_w[r][nt] * (16383.0f / 2.5f) + 0.5f)); ent[ix + 2] = __builtin_bit_cast(int, sel_rs[r]); } }
        LDS_BARRIER();
#pragma unroll
        for (int i = 0; i < 2; ++i) { const int ei = tid + 512 * i, pos = ent[ei * 3], pl = pos & 32767, rr = pl & 127, tok = item * 128 + (ei >> 3);
            LIST[pos] = ent[ei * 3 + 1]; RSL[pos] = __builtin_bit_cast(float, ent[ei * 3 + 2]);
            TOKP[(pos & ~32767) + (pl & ~127) + (rr & 63) * 2 + (rr >> 6)] = (unsigned short)tok; }
        LDS_BARRIER();
    }
}

__device__ __forceinline__ void build_bst(Frame& F, volatile LAS int* bst) {
    if (F.wave == 0) { const unsigned* cnt = F.ctl + CW_CNT; const int lane = lane_id(); const int nb = ((int)cnt[lane] + 255) >> 8; int s = nb;
#pragma unroll
        for (int o = 1; o < 64; o <<= 1) { const int t = __shfl_up(s, o); if (lane >= o) s += t; }
        bst[lane] = s - nb; bst[66 + lane] = (int)cnt[lane]; if (lane == 63) { bst[64] = s; bst[65] = s + T / 256; bst[66 + 64] = T; } }
    __syncthreads();
}

using pg8::v8i32; using pg8::v8u32;
__host__ __device__ __forceinline__ int dn_perm(int rho) { const int nt = rho >> 4, q = (rho >> 2) & 3, j = rho & 3; return ((nt >> 2) << 6) + 16 * q + 4 * (nt & 3) + j; }
__device__ __forceinline__ void down_phase(Frame& F, const volatile LAS int* bst) {
    const int lane = lane_id(), w = F.wave, fr = lane & 15, fq = lane >> 4, tid = w * 64 + lane;
    LAS unsigned char* L = F.lds;
    const unsigned char* Wd = WSP(const unsigned char, WS_WD); const unsigned char* HA = (const unsigned char*)F.out;
    const unsigned* LISTP = WSP(const unsigned, WS_LIST);
    unsigned char* CT = WSP(unsigned char, WS_CONTRIB); unsigned char* C9 = WSP(unsigned char, WS_CONTRIB9); unsigned char* TR = WSP(unsigned char, WS_TRASH);
    const int NBt = bst[65], Q = (NBt + 7) >> 3, x = F.c & 7, jj = F.c >> 3, per = F.G >> 3;
    int hiL = (x + 1) * Q; hiL = hiL < NBt ? hiL : NBt;
#define DN_UNIT(i_) ((((i_) * per + jj) < Q && (x * Q + (i_) * per + jj) < hiL) ? (x * Q + (i_) * per + jj) : -1)
    unsigned voff[4];
#pragma unroll
    for (int i = 0; i < 4; ++i) { const int s_ = i * 512 + tid, rho = s_ >> 4, p = s_ & 15; voff[i] = (unsigned)(dn_perm(rho) * 256 + ((p ^ (rho & 15)) << 4)); }
#define DN_STAGE(slot_, e_, c_) do { const unsigned char* gb_ = Wd + ((size_t)(e_) * 1024 + 128 * (c_)) * 256; _Pragma("unroll") for (int i_ = 0; i_ < 4; ++i_) \
        __builtin_amdgcn_global_load_lds((const unsigned*)(gb_ + voff[i_]), (LAS unsigned*)(L + (slot_) * 32768 + i_ * 8192 + w * 1024), 16, 0, 0); } while (0)
#define DN_WAIT4() asm volatile("s_waitcnt vmcnt(4)" ::: "memory")
#define DN_BAR() do { asm volatile("s_waitcnt lgkmcnt(0)" ::: "memory"); __builtin_amdgcn_s_barrier(); asm volatile("" ::: "memory"); } while (0)
    const int boffs0 = fr * 256 + (((2 * fq) ^ fr) << 4), boffs1 = fr * 256 + (((2 * fq + 1) ^ fr) << 4), boffs2 = fr * 256 + (((8 + 2 * fq) ^ fr) << 4), boffs3 = fr * 256 + (((8 + 2 * fq + 1) ^ fr) << 4);
#define DN_LDB(D0, D1, sb_, nt_) do { D0 = __builtin_bit_cast(v8i32, (v8u32)__builtin_shufflevector(*(const LAS v4u*)((sb_) + (nt_) * 4096 + boffs0), *(const LAS v4u*)((sb_) + (nt_) * 4096 + boffs1), 0, 1, 2, 3, 4, 5, 6, 7)); \
        D1 = __builtin_bit_cast(v8i32, (v8u32)__builtin_shufflevector(*(const LAS v4u*)((sb_) + (nt_) * 4096 + boffs2), *(const LAS v4u*)((sb_) + (nt_) * 4096 + boffs3), 0, 1, 2, 3, 4, 5, 6, 7)); } while (0)
#define DN_COMPUTE(ACC, slot_) do { const LAS unsigned char* sb_ = L + (slot_) * 32768; v8i32 bc0_, bc1_, bn0_, bn1_; DN_LDB(bc0_, bc1_, sb_, 0); \
        _Pragma("unroll") for (int nt = 0; nt < 8; ++nt) { \
            if (nt < 7) DN_LDB(bn0_, bn1_, sb_, nt + 1); \
            _Pragma("unroll") for (int mt = 0; mt < 2; ++mt) { \
                ACC[mt][nt] = __builtin_amdgcn_mfma_scale_f32_16x16x128_f8f6f4(bc0_, Af[mt][0], (f32x4){0.f, 0.f, 0.f, 0.f}, 0, 0, 0, 0x79797979, 0, 0x7C7C7C7C); \
                ACC[mt][nt] = __builtin_amdgcn_mfma_scale_f32_16x16x128_f8f6f4(bc1_, Af[mt][1], ACC[mt][nt], 0, 0, 0, 0x79797979, 0, 0x7C7C7C7C); } \
            __builtin_amdgcn_sched_barrier(0); bc0_ = bn0_; bc1_ = bn1_; } \
        _Pragma("unroll") for (int nt = 0; nt < 8; ++nt) { asm volatile("" : "+v"(ACC[0][nt]), "+v"(ACC[1][nt])); } } while (0)
#define DN_EPI(ACC, pc_) do { _Pragma("unroll") for (int mt = 0; mt < 2; ++mt) { const int r_ = 32 * w + 16 * mt + fr; const unsigned wd_ = pe_sgp[mt]; const bool routed_ = pe_e < 64; \
        const float gs_ = routed_ ? (float)(wd_ & 16383u) * (2.5f * CSCALE / 16383.0f) : CSCALE; \
        unsigned char* cp_ = routed_ ? CT + (size_t)(wd_ >> 14) * 1024 : C9 + (size_t)(pe_rb * 256 + r_) * 1024; cp_ = (r_ < pe_nv) ? cp_ : TR; cp_ += (pc_) * 128 + 16 * fq; \
        _Pragma("unroll") for (int hh = 0; hh < 2; ++hh) { unsigned wq_[4]; \
            _Pragma("unroll") for (int q = 0; q < 4; ++q) { const f32x4 v_ = ACC[mt][4 * hh + q] * gs_; int p_ = __builtin_amdgcn_cvt_pk_fp8_f32(v_[0], v_[1], 0, false); p_ = __builtin_amdgcn_cvt_pk_fp8_f32(v_[2], v_[3], p_, true); wq_[q] = (unsigned)p_; } \
            *(v4u*)(cp_ + 64 * hh) = (v4u){wq_[0], wq_[1], wq_[2], wq_[3]}; } } } while (0)
#define DN_LOADA(DST, SG, blk_, e_, rb_) do { _Pragma("unroll") for (int mt = 0; mt < 2; ++mt) { const int r_ = 32 * w + 16 * mt + fr; const unsigned char* ap_ = HA + ((size_t)(blk_) * 256 + r_) * 256 + 32 * fq; \
        _Pragma("unroll") for (int ks = 0; ks < 2; ++ks) DST[mt][ks] = __builtin_bit_cast(v8i32, (v8u32)__builtin_shufflevector(__builtin_nontemporal_load((const v4u*)(ap_ + ks * 128)), __builtin_nontemporal_load((const v4u*)(ap_ + ks * 128 + 16)), 0, 1, 2, 3, 4, 5, 6, 7)); \
        SG[mt] = LISTP[(size_t)((e_) < 64 ? (e_) : 0) * 32768 + (rb_) * 256 + r_]; } } while (0)
    int blk = DN_UNIT(0);
    if (blk < 0) return;
    int e = find_expert(bst, blk), rb = blk - bst[e], nv = bst[66 + e] - rb * 256; nv = nv > 256 ? 256 : nv;
    v8i32 Af[2][2]; unsigned sgp[2];
    f32x4 accA[2][8], accB[2][8];
    int pe_e = 0, pe_rb = 0, pe_nv = 0; unsigned pe_sgp[2] = {0u, 0u}; bool pend = false;
    DN_STAGE(0, e, 0); DN_STAGE(1, e, 1);
    DN_LOADA(Af, sgp, blk, e, rb);
    int g = 0;
    for (int ui = 0;; ++ui) {
        const int blk_n = DN_UNIT(ui + 1); const bool has_next = blk_n >= 0;
        int e_n = e, rb_n = rb, nv_n = nv;
        if (has_next) { e_n = find_expert(bst, blk_n); rb_n = blk_n - bst[e_n]; nv_n = bst[66 + e_n] - rb_n * 256; nv_n = nv_n > 256 ? 256 : nv_n; }
#pragma unroll
        for (int c = 0; c < 8; ++c) {
            if (c == 0) asm volatile("s_waitcnt vmcnt(14)" ::: "memory"); else DN_WAIT4();
            DN_BAR();
            if (c == 0) { if (pend) DN_EPI(accB, 7);
                pe_e = e; pe_rb = rb; pe_nv = nv; pe_sgp[0] = sgp[0]; pe_sgp[1] = sgp[1]; }
            else if (c & 1) DN_EPI(accA, c - 1); else DN_EPI(accB, c - 1);
            asm volatile("" ::: "memory");
            if (c != 0) { const int s2 = (g + 2) % 3; if (c < 6) DN_STAGE(s2, e, c + 2); else DN_STAGE(s2, e_n, c - 6); }
            asm volatile("" ::: "memory");
            { const int s0 = g % 3; if (c & 1) DN_COMPUTE(accB, s0); else DN_COMPUTE(accA, s0); }
            if (c == 0) { asm volatile("" ::: "memory"); DN_STAGE((g + 2) % 3, e, 2); asm volatile("" ::: "memory"); }
            ++g;
        }
        pend = true;
        if (!has_next) break;
        blk = blk_n; e = e_n; rb = rb_n; nv = nv_n;
        DN_LOADA(Af, sgp, blk, e, rb);
    }
    DN_EPI(accB, 7);
    asm volatile("s_waitcnt vmcnt(0)" ::: "memory");
#undef DN_UNIT
#undef DN_STAGE
#undef DN_WAIT4
#undef DN_BAR
#undef DN_COMPUTE
#undef DN_LDB
#undef DN_EPI
#undef DN_LOADA
}

__device__ __forceinline__ void combine_phase(Frame& F) {
    const int gw = F.c * NWAVES + F.wave, NGW = F.G * NWAVES, lane = lane_id();
    const bf16* HB = WSP(const bf16, WS_HB); const unsigned char* CT = WSP(const unsigned char, WS_CONTRIB); const unsigned char* C9 = WSP(const unsigned char, WS_CONTRIB9);
    f32x4 gg[4];
    { const f32x4* gp = (const f32x4*)(karg_in(19) + lane * 16);
#pragma unroll
      for (int q = 0; q < 4; ++q) gg[q] = gp[q]; }
    v4u nh0, nh1, nc[9];
#define P9_LOAD(tt) do { nh0 = __builtin_nontemporal_load((const v4u*)(HB + (size_t)(tt) * D + lane * 16)); nh1 = __builtin_nontemporal_load((const v4u*)(HB + (size_t)(tt) * D + lane * 16 + 8)); \
        _Pragma("unroll") for (int k = 0; k < 9; ++k) nc[k] = __builtin_nontemporal_load((const v4u*)((k < 8 ? CT + ((size_t)(tt) * 8 + k) * 1024 : C9 + (size_t)(tt) * 1024) + lane * 16)); } while (0)
    int t = gw;
    if (t < T) P9_LOAD(t);
    for (; t < T; t += NGW) {
        const v4u h0 = nh0, h1 = nh1; v4u cw[9];
#pragma unroll
        for (int k = 0; k < 9; ++k) cw[k] = nc[k];
        if (t + NGW < T) P9_LOAD(t + NGW);
        float v[16];
        v[0] = bflo(h0.x); v[1] = bfhi(h0.x); v[2] = bflo(h0.y); v[3] = bfhi(h0.y); v[4] = bflo(h0.z); v[5] = bfhi(h0.z); v[6] = bflo(h0.w); v[7] = bfhi(h0.w);
        v[8] = bflo(h1.x); v[9] = bfhi(h1.x); v[10] = bflo(h1.y); v[11] = bfhi(h1.y); v[12] = bflo(h1.z); v[13] = bfhi(h1.z); v[14] = bflo(h1.w); v[15] = bfhi(h1.w);
#pragma unroll
        for (int k = 0; k < 9; ++k) { const unsigned w4[4] = {cw[k].x, cw[k].y, cw[k].z, cw[k].w};
#pragma unroll
            for (int q = 0; q < 4; ++q) { const f32x2 lo = __builtin_amdgcn_cvt_pk_f32_fp8((int)w4[q], false), hi = __builtin_amdgcn_cvt_pk_f32_fp8((int)w4[q], true);
                v[4 * q + 0] += lo.x * CINV; v[4 * q + 1] += lo.y * CINV; v[4 * q + 2] += hi.x * CINV; v[4 * q + 3] += hi.y * CINV; } }
        float ss = 0.f;
#pragma unroll
        for (int j = 0; j < 16; ++j) ss += v[j] * v[j];
        const float rstd = 1.0f / sqrtf(wave_sum(ss) * (1.f / D) + EPS);
        f32x4* op = (f32x4*)(F.out + (size_t)t * D + lane * 16);
#pragma unroll
        for (int q = 0; q < 4; ++q) { const f32x4 g = gg[q]; op[q] = (f32x4){v[4 * q] * rstd * g.x, v[4 * q + 1] * rstd * g.y, v[4 * q + 2] * rstd * g.z, v[4 * q + 3] * rstd * g.w}; }
    }
#undef P9_LOAD
}

constexpr int N_PHASES = 10;
__global__ void __launch_bounds__(NWAVES * 64, 2) fwd(Args args) {
    extern __shared__ __attribute__((aligned(16))) unsigned char lds[];
    Frame F;
    F.lds = (LAS unsigned char*)lds; F.MISC = (volatile LAS unsigned*)(F.lds + MISC_OFF);
    F.wave = __builtin_amdgcn_readfirstlane((int)threadIdx.x >> 6);
    F.G = gridDim.x; F.c = blockIdx.x; F.variant = args.variant; F.ws = args.ws; F.out = args.out; F.ctl = (unsigned*)(args.ws + WS_CTL);
    for (int u = (F.wave * 64 + lane_id()); u < 256; u += NWAVES * 64) ((LAS unsigned*)(F.lds + MISC_OFF))[u] = 0u;
    __syncthreads();
    XcdBarrier bar; bar.bar = F.ctl + CW_BAR + args.li * XCD_BAR_WORDS; bar.x = 0; bar.st = nullptr; bar.wave = 0;
    const int lo = args.ph_lo, hi = args.ph_hi;
    if (hi - lo > 1) bar = xcd_barrier_post(F.ctl + CW_BAR + args.li * XCD_BAR_WORDS, F.MISC + 8, F.wave);
#ifndef PH_MASK
#define PH_MASK 0x3ff
#endif
#define IN(k) (((PH_MASK >> (k)) & 1) && lo <= (k) && (k) < hi)
#define SEAM(k) do { if (IN(k) && IN((k) + 1)) xcd_barrier(bar); } while (0)
    volatile LAS int* bst = (volatile LAS int*)(F.MISC + 64);

    if (IN(0)) { p0_prologue(F); } SEAM(0);
    if (IN(1)) {
        StaticOrder S; S.init(WSP(bf16, WS_XN), WSP(bf16, WS_WIN), T, DIN, D, D, D, F.G, F.c);
        EpiZ E{WSP(bf16, WS_Z), WSP(const float, WS_RSTD1), WSP(bf16, WS_CF)};
        pg8::gemm_phase<EpiZ, StaticOrder, true, false>(F.lds, S, E, F.wave);
    } SEAM(1);
    if (IN(2)) { for (int it = F.c; it < T / 128; it += F.G) sgu_item(F, it); }
    if (IN(3)) { f2_phase(F); } SEAM(3);
    if (IN(4)) { for (int it = F.c; it < T / 64; it += F.G) f3_item(F, it); } SEAM(4);
    if (IN(5)) {
        StaticOrder S; S.init(WSP(bf16, WS_MIX), WSP(bf16, WS_WOUT), T, D, D, D, D, F.G, F.c);
        EpiH E{WSP(const bf16, WS_XN), WSP(bf16, WS_HB), WSP(float, WS_SSP), WSP(unsigned char, WS_HB8)};
        pg8::gemm_phase<EpiH, StaticOrder, true, false>(F.lds, S, E, F.wave);
    } SEAM(5);
#if DBG_STOP >= 6
    if (IN(6)) { route_phase(F); } SEAM(6);
#endif
#if DBG_STOP >= 7
    if (IN(7)) {
        build_bst(F, bst);
        SchedGU S; S.hb = (const char*)WSP(unsigned char, WS_HB8); S.Wgu = (const char*)WSP(unsigned char, WS_WGU); S.tokp = WSP(const unsigned short, WS_TOKP); S.cnt = F.ctl + CW_CNT; S.bst = bst;
        S.K = 512; S.lda = 512; S.ldb = 512; S.G = F.G; S.c = F.c; S.NU = 2 * bst[65]; S.Q = (S.NU + 7) / 8;
        EpiGU E{WSP(const float, WS_RSL), WSP(const float, WS_RSTD2), (unsigned char*)F.out, bst};
        pg8::gemm_phase<EpiGU, SchedGU, true, true, true>(F.lds, S, E, F.wave);
    } SEAM(7);
#endif
#if DBG_STOP >= 8
    if (IN(8)) {
        build_bst(F, bst);
        down_phase(F, bst);
    } SEAM(8);
#endif
    if (IN(9)) { combine_phase(F); }
#undef IN
#undef SEAM
}

extern "C" void kernel_launch(void* const* d_in, const int* in_sizes, int n_in, void* d_out, int out_size, void* d_ws, size_t ws_size, hipStream_t stream) {
    static int grid = 0;
    if (grid == 0) {
        if (n_in != 20 || in_sizes[0] != T * D || out_size != T * D || ws_size < WS_END) { fprintf(stderr, "kernel_launch: unexpected shapes / workspace (n_in %d, in0 %d, out %d, ws %zu)\n", n_in, n_in > 0 ? in_sizes[0] : -1, out_size, ws_size); grid = -1; return; }
        int dev = 0, cus = 0, per_cu = 0;
        if (hipGetDevice(&dev) != hipSuccess || hipDeviceGetAttribute(&cus, hipDeviceAttributeMultiprocessorCount, dev) != hipSuccess) { grid = -1; return; }
        if (hipFuncSetAttribute((const void*)fwd, hipFuncAttributeMaxDynamicSharedMemorySize, LDS_BYTES) != hipSuccess) { fprintf(stderr, "kernel_launch: hipFuncSetAttribute failed\n"); grid = -1; return; }
        if (hipOccupancyMaxActiveBlocksPerMultiprocessor(&per_cu, (const void*)fwd, NWAVES * 64, LDS_BYTES) != hipSuccess || per_cu < 1) fprintf(stderr, "kernel_launch: occupancy query reports %d\n", per_cu);
        (void)hipGetLastError();
        grid = cus;
        if (grid % 8 != 0 || grid > 1024) { fprintf(stderr, "kernel_launch: unexpected CU count %d\n", cus); }
    }
    if (grid < 0) return;
    if (hipMemsetAsync((char*)d_ws + WS_CTL, 0, CTL_ZERO_BYTES, stream) != hipSuccess) return;
    Args a{};
    for (int i = 0; i < 20; ++i) a.in[i] = (const float*)d_in[i];
    a.out = (float*)d_out; a.ws = (unsigned char*)d_ws;
    const int nl = MK_N_LAUNCHES;
    for (int li = 0; li < nl; ++li) {
        a.ph_lo = (nl == N_PHASES) ? li : (li * N_PHASES) / nl; a.ph_hi = (nl == N_PHASES) ? li + 1 : ((li + 1) * N_PHASES) / nl; a.li = li;
#if defined(REP_MASK)
        if (nl == N_PHASES && ((REP_MASK >> li) & 1)) for (int rep = 0; rep < REP_N; ++rep) { a.variant = REP_VARIANT; hipLaunchKernelGGL(fwd, dim3(grid), dim3(NWAVES * 64), LDS_BYTES, stream, a); a.variant = 0;
            if (li == 6) (void)hipMemsetAsync((char*)d_ws + WS_CTL + CW_CNT * 4, 0, 256, stream); }
#endif
        hipLaunchKernelGGL(fwd, dim3(grid), dim3(NWAVES * 64), LDS_BYTES, stream, a);
        if (hipPeekAtLastError() != hipSuccess) { fprintf(stderr, "kernel_launch: launch %d failed\n", li); break; }

    }
}
```
